# Optimizing an MI355X kernel written in HIP

```python
import functools
import jax, jax.numpy as jnp
from jax import lax
import numpy as np

D_MODEL = 1024
BATCH = 1
SEQ = 16384
DEPTH = 1
DEC_BATCH = 128
DEC_SEQ = 8
PAST_LEN = 16384
PAGE_SIZE = 128

N_META = 16
N_HEADS = 16
HEAD_DIM = 64
N_KV_HEADS = 4
GROUP = N_HEADS // N_KV_HEADS
WINDOW = 128
ATTN_WIDTH = N_HEADS * HEAD_DIM
KV_WIDTH = N_KV_HEADS * HEAD_DIM
HG_EXPAND = 128
HG_HEADS = D_MODEL // HG_EXPAND
HG_KDIM = HG_EXPAND
HG_VDIM = D_MODEL // HG_HEADS
HG_FWIDTH = HG_HEADS * HG_KDIM
HG_VWIDTH = HG_HEADS * HG_VDIM
HG_CHUNK = 64
D_FF = 2816
CONV_W = 3
SPLIT_SIZES = (ATTN_WIDTH, KV_WIDTH, KV_WIDTH, HG_FWIDTH, HG_FWIDTH, HG_VWIDTH, HG_VWIDTH, D_MODEL, D_MODEL)
IN_COLS = sum(SPLIT_SIZES)
DEEPNORM_ALPHA = (2.0 * DEPTH) ** 0.25
DEEPNORM_BETA = (8.0 * DEPTH) ** -0.25
LN_EPS = 1e-5
RMS_EPS = 1e-6
NEG_INF = -1e30

kernel_name = 'hybrid_swa_sink_hgrn2_convffn_step'


def layer_norm(x, g, b):
    xf = x.astype(jnp.float32)
    mu = jnp.mean(xf, axis=-1, keepdims=True)
    var = jnp.mean(jnp.square(xf - mu), axis=-1, keepdims=True)
    return ((xf - mu) * lax.rsqrt(var + LN_EPS) * g.astype(jnp.float32) + b.astype(jnp.float32)).astype(x.dtype)


def rms_norm(x, g):
    xf = x.astype(jnp.float32)
    return xf * lax.rsqrt(jnp.mean(xf * xf, axis=-1, keepdims=True) + RMS_EPS) * g.astype(jnp.float32)


def split_columns(z):
    offsets = np.cumsum(SPLIT_SIZES)[:-1].tolist()
    return jnp.split(z, offsets, axis=-1)


def sink_attention(q, k, v, mask, sinks):
    s = jnp.einsum('...tkgd,...skd->...kgts', q, k, preferred_element_type=jnp.float32) * (HEAD_DIM ** -0.5)
    s = jnp.where(mask, s, NEG_INF)
    sink = jnp.broadcast_to(sinks.astype(jnp.float32).reshape(N_KV_HEADS, GROUP, 1, 1), s.shape[:-1] + (1,))
    p = jax.nn.softmax(jnp.concatenate([s, sink], axis=-1), axis=-1)[..., :-1]
    return jnp.einsum('...kgts,...skd->...tkgd', p.astype(v.dtype), v)


def swa_prompt(q, k, v, sinks):
    B, L = q.shape[:2]
    pad = (-N_META) % WINDOW
    nb = (L + pad) // WINDOW
    padt = lambda a: jnp.pad(a, ((0, 0), (pad, 0), (0, 0), (0, 0)))
    qb = padt(q).reshape(B, nb, WINDOW, N_KV_HEADS, GROUP, HEAD_DIM)

    def band_keys(a):
        blocks = padt(a).reshape(B, nb, WINDOW, N_KV_HEADS, HEAD_DIM)
        prev = jnp.pad(blocks, ((0, 0), (1, 0), (0, 0), (0, 0), (0, 0)))[:, :-1]
        meta = jnp.broadcast_to(a[:, None, :N_META], (B, nb, N_META, N_KV_HEADS, HEAD_DIM))
        return jnp.concatenate([meta, prev, blocks], axis=2)

    kk = band_keys(k)
    vv = band_keys(v)
    qpos = (jnp.arange(nb * WINDOW) - pad).reshape(nb, WINDOW)
    qp = qpos[:, :, None]
    kpos = jnp.concatenate([qpos - WINDOW, qpos], axis=1)[:, None, :]
    band_ok = (kpos >= N_META) & (kpos <= qp) & (kpos > qp - WINDOW)
    meta_ok = jnp.arange(N_META)[None, None, :] <= qp
    mask = jnp.concatenate([meta_ok, band_ok], axis=-1)
    o = sink_attention(qb, kk, vv, mask[None, :, None, None], sinks)
    o = o.reshape(B, nb * WINDOW, ATTN_WIDTH)[:, pad:]
    return o, (k[:, :N_META], v[:, :N_META], k[:, -WINDOW:], v[:, -WINDOW:])


def swa_sample(q, k, v, meta_k, meta_v, win_k, win_v, sinks):
    B, T = q.shape[:2]
    band_k = jnp.concatenate([win_k.astype(k.dtype), k], axis=1)
    band_v = jnp.concatenate([win_v.astype(v.dtype), v], axis=1)
    kk = jnp.concatenate([meta_k.astype(k.dtype), band_k], axis=1)
    vv = jnp.concatenate([meta_v.astype(v.dtype), band_v], axis=1)
    j = jnp.arange(T)[:, None]
    idx = jnp.arange(WINDOW + T)[None, :]
    band_ok = (idx > j) & (idx <= WINDOW + j) & (PAST_LEN - WINDOW + idx >= N_META)
    mask = jnp.concatenate([jnp.ones((T, N_META), bool), band_ok], axis=1)
    o = sink_attention(q.reshape(B, T, N_KV_HEADS, GROUP, HEAD_DIM), kk, vv, mask, sinks)
    return o.reshape(B, T, ATTN_WIDTH), (band_k[:, -WINDOW:], band_v[:, -WINDOW:])


def hgrn_gates(hq, hf, hi, lb):
    B, T = hq.shape[:2]
    f = lb + (1.0 - lb) * jax.nn.sigmoid(hf.astype(jnp.float32))
    heads = lambda a, d: a.reshape(B, T, HG_HEADS, d)
    q = heads(jax.nn.silu(hq.astype(jnp.float32)), HG_KDIM)
    k = heads(1.0 - f, HG_KDIM)
    log_f = heads(jnp.log(f), HG_KDIM)
    v = heads(hi.astype(jnp.float32), HG_VDIM)
    return q, k, v, log_f


def hgrn_prompt(q, k, v, log_f):
    B, L = q.shape[:2]
    pad = (-N_META) % HG_CHUNK
    padt = lambda a: jnp.pad(a, ((0, 0), (pad, 0), (0, 0), (0, 0)))
    nc = (L + pad) // HG_CHUNK
    rs = lambda a: padt(a).reshape(B, nc, HG_CHUNK, HG_HEADS, a.shape[-1])
    q, k, v, log_f = rs(q), rs(k), rs(v), rs(log_f)
    b = jnp.cumsum(log_f, axis=2)
    b_last = b[:, :, -1:]
    q_d = q * jnp.exp(b)
    k_d = k * jnp.exp(-b)
    k_end = k * jnp.exp(b_last - b)
    causal = jnp.tril(jnp.ones((HG_CHUNK, HG_CHUNK), bool))
    scores = jnp.where(causal, jnp.einsum('bnthd,bnshd->bnhts', q_d, k_d), 0.0)
    o_intra = jnp.einsum('bnhts,bnshv->bnthv', scores, v)
    chunk_state = jnp.einsum('bnshd,bnshv->bnhdv', k_end, v)
    decay = jnp.exp(b_last[:, :, 0])

    def step(S, inp):
        dec, cs = inp
        return dec[..., None] * S + cs, S

    S0 = jnp.zeros((B, HG_HEADS, HG_KDIM, HG_VDIM), jnp.float32)
    S_final, S_prev = lax.scan(step, S0, (jnp.swapaxes(decay, 0, 1), jnp.swapaxes(chunk_state, 0, 1)))
    o_inter = jnp.einsum('bnthd,bnhdv->bnthv', q_d, jnp.swapaxes(S_prev, 0, 1))
    o = (o_intra + o_inter).reshape(B, nc * HG_CHUNK, HG_HEADS, HG_VDIM)[:, pad:]
    return o, S_final


def hgrn_sample(q, k, v, log_f, s0):
    def step(S, inp):
        q_t, k_t, v_t, lf_t = inp
        S = jnp.exp(lf_t)[..., None] * S + k_t[..., None] * v_t[..., None, :]
        return S, jnp.einsum('bhd,bhdv->bhv', q_t, S)

    tm = lambda a: jnp.swapaxes(a, 0, 1)
    S, o = lax.scan(step, s0.astype(jnp.float32), (tm(q), tm(k), tm(v), tm(log_f)))
    return tm(o), S


def conv_ffn(x, conv_buf, w_up_l, conv_w_l, conv_b_l, w_down_l):
    T = x.shape[1]
    u, val = jnp.split(x @ w_up_l, 2, axis=-1)
    u_ext = jnp.concatenate([conv_buf.astype(u.dtype), u], axis=1)
    c = conv_b_l + sum(conv_w_l[j] * u_ext[:, j:j + T] for j in range(CONV_W))
    h = jax.nn.gelu(c) * val
    return h @ w_down_l, u_ext[:, -(CONV_W - 1):]


def trunk_layer(x, attn_fn, hgrn_fn, conv_buf, lb, w_in_l, norm_g_l, w_out_l, ln1_g_l, ln1_b_l,
                w_up_l, conv_w_l, conv_b_l, w_down_l, ln2_g_l, ln2_b_l):
    B, T = x.shape[:2]
    qa, ka, va, hq, hf, hi, hg, ga, gb = split_columns(x @ w_in_l)
    o_attn, attn_state = attn_fn(qa.reshape(B, T, N_HEADS, HEAD_DIM),
                                 ka.reshape(B, T, N_KV_HEADS, HEAD_DIM),
                                 va.reshape(B, T, N_KV_HEADS, HEAD_DIM))
    q, k, v, log_f = hgrn_gates(hq, hf, hi, lb)
    o_hg, hg_state = hgrn_fn(q, k, v, log_f)
    o_hg = rms_norm(o_hg.reshape(B, T, HG_VWIDTH), norm_g_l).astype(x.dtype) * jax.nn.silu(hg)
    merged = jax.nn.sigmoid(ga) * o_attn + jax.nn.sigmoid(gb) * o_hg
    x = layer_norm(DEEPNORM_ALPHA * x + merged @ w_out_l, ln1_g_l, ln1_b_l)
    ffn_out, conv_state = conv_ffn(x, conv_buf, w_up_l, conv_w_l, conv_b_l, w_down_l)
    x = layer_norm(DEEPNORM_ALPHA * x + ffn_out, ln2_g_l, ln2_b_l)
    return x, attn_state, hg_state, conv_state


def setup_inputs(seed: int = 0) -> dict:
    key = jax.random.key(seed)
    ks = jax.random.split(key, 22)

    def nrm(k, shape, scale):
        return jax.random.normal(k, shape, jnp.float32) * scale

    meta_shape = (DEPTH, DEC_BATCH, N_META, N_KV_HEADS, HEAD_DIM)
    win_shape = (DEPTH, DEC_BATCH, WINDOW, N_KV_HEADS, HEAD_DIM)
    return {
        'x_prompt': nrm(ks[0], (BATCH, SEQ, D_MODEL), 1.0),
        'x_sample': nrm(ks[1], (DEC_BATCH, DEC_SEQ, D_MODEL), 1.0),
        'cache_meta_k': nrm(ks[2], meta_shape, 1.0),
        'cache_meta_v': nrm(ks[3], meta_shape, 1.0),
        'cache_win_k': nrm(ks[4], win_shape, 1.0),
        'cache_win_v': nrm(ks[5], win_shape, 1.0),
        'state_hgrn': nrm(ks[6], (DEPTH, DEC_BATCH, HG_HEADS, HG_KDIM, HG_VDIM), 0.5),
        'state_conv': nrm(ks[7], (DEPTH, DEC_BATCH, CONV_W - 1, D_FF), 1.0),
        'meta_tokens': nrm(ks[8], (N_META, D_MODEL), 1.0),
        'w_in': nrm(ks[9], (DEPTH, D_MODEL, IN_COLS), D_MODEL ** -0.5),
        'attn_sinks': nrm(ks[10], (DEPTH, N_HEADS), 0.5),
        'hgrn_lb': nrm(ks[11], (DEPTH + 1, HG_FWIDTH), 0.1),
        'hgrn_norm_g': 1.0 + nrm(ks[12], (DEPTH, HG_VWIDTH), 0.05),
        'w_out': nrm(ks[13], (DEPTH, D_MODEL, D_MODEL), DEEPNORM_BETA * D_MODEL ** -0.5),
        'ln1_g': 1.0 + nrm(ks[14], (DEPTH, D_MODEL), 0.05),
        'ln1_b': nrm(ks[15], (DEPTH, D_MODEL), 0.02),
        'w_up': nrm(ks[16], (DEPTH, D_MODEL, 2 * D_FF), D_MODEL ** -0.5),
        'conv_w': nrm(ks[17], (DEPTH, CONV_W, D_FF), CONV_W ** -0.5),
        'conv_b': nrm(ks[18], (DEPTH, D_FF), 0.02),
        'w_down': nrm(ks[19], (DEPTH, D_FF, D_MODEL), DEEPNORM_BETA * D_FF ** -0.5),
        'ln2_g': 1.0 + nrm(ks[20], (DEPTH, D_MODEL), 0.05),
        'ln2_b': nrm(ks[21], (DEPTH, D_MODEL), 0.02),
    }


def reference(x_prompt, x_sample, cache_meta_k, cache_meta_v, cache_win_k, cache_win_v, state_hgrn, state_conv,
              meta_tokens, w_in, attn_sinks, hgrn_lb, hgrn_norm_g, w_out, ln1_g, ln1_b,
              w_up, conv_w, conv_b, w_down, ln2_g, ln2_b):
    lb_all = jnp.cumsum(jax.nn.softmax(hgrn_lb.astype(jnp.float32), axis=0), axis=0)
    B = x_prompt.shape[0]
    xp = jnp.concatenate([jnp.broadcast_to(meta_tokens.astype(x_prompt.dtype), (B, N_META, D_MODEL)), x_prompt], axis=1)
    xs = x_sample
    p_states = []
    s_states = []
    for l in range(DEPTH):
        shared = (lb_all[l], w_in[l], hgrn_norm_g[l], w_out[l], ln1_g[l], ln1_b[l],
                  w_up[l], conv_w[l], conv_b[l], w_down[l], ln2_g[l], ln2_b[l])
        xp, p_attn, p_hg, p_conv = trunk_layer(
            xp, functools.partial(swa_prompt, sinks=attn_sinks[l]), hgrn_prompt,
            jnp.zeros((B, CONV_W - 1, D_FF), xp.dtype), *shared)
        xs, s_attn, s_hg, s_conv = trunk_layer(
            xs,
            functools.partial(swa_sample, meta_k=cache_meta_k[l], meta_v=cache_meta_v[l],
                              win_k=cache_win_k[l], win_v=cache_win_v[l], sinks=attn_sinks[l]),
            functools.partial(hgrn_sample, s0=state_hgrn[l]),
            state_conv[l], *shared)
        p_states.append(p_attn + (p_hg, p_conv))
        s_states.append(s_attn + (s_hg, s_conv))
    meta_k_prompt = jnp.stack([s[0] for s in p_states])
    meta_v_prompt = jnp.stack([s[1] for s in p_states])
    win_k_prompt = jnp.stack([s[2] for s in p_states])
    win_v_prompt = jnp.stack([s[3] for s in p_states])
    hgrn_prompt_state = jnp.stack([s[4] for s in p_states])
    conv_prompt_state = jnp.stack([s[5] for s in p_states])
    win_k_sample = jnp.stack([s[0] for s in s_states])
    win_v_sample = jnp.stack([s[1] for s in s_states])
    hgrn_sample_state = jnp.stack([s[2] for s in s_states])
    conv_sample_state = jnp.stack([s[3] for s in s_states])
    y_prompt = xp[:, N_META:]
    y_sample = xs
    return (y_prompt, y_sample, meta_k_prompt, meta_v_prompt, win_k_prompt, win_v_prompt,
            hgrn_prompt_state, conv_prompt_state, win_k_sample, win_v_sample, hgrn_sample_state, conv_sample_state)
```

```cpp
#include <hip/hip_runtime.h>
#include <hip/hip_cooperative_groups.h>
#include <cstdio>
#include <cstdint>
namespace cg = cooperative_groups;

#define LAS __attribute__((address_space(3)))
typedef unsigned short u16;
typedef short bf16x8 __attribute__((ext_vector_type(8)));
typedef float f32x4 __attribute__((ext_vector_type(4)));
typedef unsigned u32x4 __attribute__((ext_vector_type(4)));
typedef unsigned u32x2 __attribute__((ext_vector_type(2)));

constexpr int DM = 1024, NPR = 16384, NSM = 1024, NMETA = 16;
constexpr int ROW_S = 16384, ROW_M = 17408, MROWS = 17424, MPAD = 17664;
constexpr int INC = 7680, DFF = 2816, UVW = 5632;
constexpr int NBATCH = 128, NTOK = 8;
constexpr float ALPHA = 1.189207115002721f;
constexpr size_t O_Y = 0, O_METAK = 17825792, O_METAV = 17829888, O_WINKP = 17833984, O_WINVP = 17866752, O_HGP = 17899520,
                 O_CONVP = 18030592, O_WINKS = 18036224, O_WINVS = 22230528, O_HGS = 26424832, O_CONVS = 43202048;
constexpr size_t OB_Q = 0;
constexpr size_t OB_KV = (size_t)MROWS * 2048;
constexpr size_t OB_XB = O_HGS * 4;
constexpr size_t SLOT = (size_t)MROWS * 2048;
constexpr size_t W_WIN = 0, W_WUP = 0, W_WDN = (size_t)UVW * DM * 2;
constexpr size_t W_S1 = 17825792, W_S2 = W_S1 + SLOT, W_S3 = W_S2 + SLOT, W_S4 = W_S3 + SLOT, W_S5 = W_S4 + SLOT, W_S6 = W_S5 + SLOT;
constexpr size_t W_L = W_S6 + SLOT;
constexpr size_t W_UV = W_S2;
constexpr size_t W_SMALL = (size_t)250 * 1024 * 1024;
constexpr size_t W_WOUT = W_SMALL + (size_t)2 * 1024 * 1024;
constexpr size_t W_CTL = W_SMALL + (size_t)1280 * 1024;
constexpr size_t CTL_BYTES = 32768;
constexpr size_t W_HALO = W_SMALL + (size_t)4 * 1024 * 1024;
constexpr size_t W_FIXU = W_HALO + (size_t)70 * 2 * DFF * 2;
constexpr size_t W_FIXV = W_SMALL + 4096 + 131072 + 65536;
static_assert(W_FIXU + (size_t)64 * 2 * DFF * 2 <= (size_t)256 * 1024 * 1024 && W_FIXV + (size_t)64 * 2 * DFF * 2 <= W_CTL, "halo buffers");
__device__ __forceinline__ float* part_row(unsigned char* ws, int sl, int r) { return (float*)(ws + W_UV + ((size_t)sl * 1024 + r) * ((size_t)UVW * 2)); }
constexpr size_t W_LB = W_SMALL, W_DG = W_SMALL + 4096, W_YT = W_SMALL + 4096 + 131072;
constexpr size_t WS_NEED = (size_t)256 * 1024 * 1024;
static_assert(W_L + 16777216 <= W_SMALL && W_UV + (size_t)MPAD * UVW * 2 <= W_SMALL && W_YT + 1048576 <= WS_NEED, "ws layout");
static_assert(W_WOUT + 2097152 <= WS_NEED && W_WDN + (size_t)DM * DFF * 2 <= W_S1 && (size_t)INC * DM * 2 <= W_S1, "ws layout");
constexpr int LDS_BYTES = 155648;

struct Params { const float* in[22]; float* out; unsigned char* ws; int ph_lo, ph_hi, bli, pad; };

typedef __bf16 bf16x2_t __attribute__((ext_vector_type(2)));
typedef float f32x2_t __attribute__((ext_vector_type(2)));
__device__ __forceinline__ unsigned cvt_pk_bf16(float lo, float hi) { bf16x2_t r = __builtin_convertvector((f32x2_t){lo, hi}, bf16x2_t); return __builtin_bit_cast(unsigned, r); }
__device__ __forceinline__ float bf2f(u16 v) { return __uint_as_float((unsigned)v << 16); }
__device__ __forceinline__ float bflo(unsigned w) { return __uint_as_float(w << 16); }
__device__ __forceinline__ float bfhi(unsigned w) { return __uint_as_float(w & 0xffff0000u); }
__device__ __forceinline__ u16 f2bf(float f) { return (u16)(cvt_pk_bf16(f, 0.f) & 0xffffu); }
__device__ __forceinline__ float h2f(u16 v) { return (float)__builtin_bit_cast(_Float16, v); }
__device__ __forceinline__ u16 f2h(float f) { return __builtin_bit_cast(u16, (_Float16)f); }
__device__ __forceinline__ float sigmoidf_(float x) { return __builtin_amdgcn_rcpf(1.0f + __expf(-x)); }
__device__ __forceinline__ u32x4 pack8(const float* v) { u32x4 w; w.x = cvt_pk_bf16(v[0], v[1]); w.y = cvt_pk_bf16(v[2], v[3]); w.z = cvt_pk_bf16(v[4], v[5]); w.w = cvt_pk_bf16(v[6], v[7]); return w; }
__device__ __forceinline__ const float* xrow(const Params& p, int row) {
    return row < ROW_S ? p.in[0] + (size_t)row * DM : (row < ROW_M ? p.in[1] + (size_t)(row - ROW_S) * DM : p.in[8] + (size_t)(row - ROW_M) * DM);
}
__device__ __forceinline__ float* yrow(const Params& p, int row) {
    return row < ROW_M ? p.out + (size_t)row * DM : (float*)(p.ws + W_YT) + (size_t)(row - ROW_M) * DM;
}

namespace pg8 {
constexpr int BM = 256, BK = 64, HALF = 128, HTB = HALF * BK * 2, NXCD = 8, WGM = 8;
__device__ __forceinline__ int lds_byte(int r, int c) { const int st = (r >> 4) * 2 + (c >> 5), rr = r & 15, cc = c & 31, ob = rr * 64 + cc * 2; return st * 1024 + (ob ^ (((ob >> 9) & 1) << 5)); }
__device__ __forceinline__ void stage_rc(int b, int& R, int& C) { const int st = b / 1024, sb = b % 1024, swz = sb ^ (((sb >> 9) & 1) << 5); R = (st >> 1) * 16 + swz / 64; C = (st & 1) * 32 + (swz % 64) / 2; }
__device__ __forceinline__ int perm32(int rho) { const int n = rho >> 4, i = rho & 15; return 8 * (i >> 2) + 4 * n + (i & 3); }
struct Unit { int pm, pn, k0, nk, sl; };
struct Gemm { const u16* A; const u16* Bt; int M, N, K, lda, ldb; };
struct StaticOrder {
    int nM, nN, nwg, G, c, nkt;
    __device__ __forceinline__ void init(int M, int N, int K, int G_, int c_) { nM = M / BM; nN = N / BM; nwg = nM * nN; G = G_; c = c_; nkt = K / BK; }
    __device__ __forceinline__ bool next(int i, Unit& u) const {
        const long L = (long)i * G + c; if (L >= nwg) return false;
        int wgid = (int)L; { const int q = nwg / NXCD, r = nwg % NXCD, xcd = wgid % NXCD, off = wgid / NXCD; wgid = (xcd < r ? xcd * (q + 1) : r * (q + 1) + (xcd - r) * q) + off; }
        const int nig = WGM * nN, gid = wgid / nig, fm = gid * WGM, gsz = (nM - fm) < WGM ? (nM - fm) : WGM;
        u.pm = fm + ((wgid % nig) % gsz); u.pn = (wgid % nig) / gsz; u.k0 = 0; u.nk = nkt; u.sl = -1; return true;
    }
};
struct SplitOrder {
    StaticOrder base; int c;
    __device__ __forceinline__ void init(int K, int G_, int c_) { base.init(NPR, DM, K, G_, c_); c = c_; }
    __device__ __forceinline__ bool next(int i, Unit& u) const {
        if (i == 0) return base.next(0, u);
        if (i > 1 || c >= 128) return false;
        const int tile = c >> 3, sl = c & 7;
        u.pm = 64 + (tile >> 2); u.pn = tile & 3; u.sl = sl; u.k0 = sl < 6 ? sl * 6 : 36 + (sl - 6) * 4; u.nk = sl < 6 ? 6 : 4; return true;
    }
};
struct TailOrder {
    StaticOrder base; int c;
    __device__ __forceinline__ void init(int K, int G_, int c_) { base.init(NPR, DM, K, G_, c_); c = c_; }
    __device__ __forceinline__ bool next(int i, Unit& u) const {
        if (i == 0) return base.next(0, u);
        if (i > 1 || c >= 40) return false;
        const int tile = c >> 1, h = c & 1;
        u.pm = 64 + (tile >> 2); u.pn = tile & 3; u.k0 = h * (base.nkt >> 1); u.nk = base.nkt >> 1; u.sl = h; return true;
    }
};
template <class Epi, class Sched>
__device__ __forceinline__ void gemm_phase(LAS unsigned char* lds, const Gemm g, const Sched& S, const Epi& E) {
    const int tid = threadIdx.x, wid = __builtin_amdgcn_readfirstlane(tid >> 6), lane = tid & 63, wr = wid >> 2, wc = wid & 3, fr = lane & 15, fq = lane >> 4;
    unsigned voffA[2], voffB[2];
#pragma unroll
    for (int i = 0; i < 2; ++i) { int R, C; stage_rc(tid * 16 + i * 8192, R, C); const int Rb = (R & ~31) + perm32(R & 31);
        voffA[i] = (unsigned)(R * g.lda + C) * 2u; voffB[i] = (unsigned)(Rb * g.ldb + C) * 2u; }
    const size_t kstep = (size_t)(BK * 2);
    const size_t hstepA = (size_t)HALF * g.lda * 2, hstepB = (size_t)HALF * g.ldb * 2;
    const size_t tstepA = 2 * hstepA, tstepB = 2 * hstepB;
    const unsigned ldsw = (unsigned)wid * 1024u;
    const int aoff = lds_byte(wr * 64 + fr, fq * 8), boff = lds_byte(wc * 32 + fr, fq * 8);
#define PG8_SA(b, h) (((b) * 2 + (h)) * HTB)
#define PG8_SB(b, h) ((4 + (b) * 2 + (h)) * HTB)
#define PG8_STAGE(bufoff, gbase, voff) do { _Pragma("unroll") for (int _i = 0; _i < 2; ++_i) \
        __builtin_amdgcn_global_load_lds((const unsigned*)((const char*)(gbase) + (voff)[_i]), (LAS unsigned*)(lds + (bufoff) + ldsw + _i * 8192), 16, 0, 0); } while (0)
#define PG8_LDA(dst, b, h) do { _Pragma("unroll") for (int m = 0; m < 4; ++m) _Pragma("unroll") for (int k = 0; k < 2; ++k) dst[m][k] = *(const LAS bf16x8*)(lds + PG8_SA(b, h) + aoff + m * 2048 + k * 1024); } while (0)
#define PG8_LDB(dst, b, h) do { _Pragma("unroll") for (int n = 0; n < 2; ++n) _Pragma("unroll") for (int k = 0; k < 2; ++k) dst[n][k] = *(const LAS bf16x8*)(lds + PG8_SB(b, h) + boff + n * 2048 + k * 1024); } while (0)
#define PG8_MMA(ai, bj, At, Bt) do { __builtin_amdgcn_s_setprio(1); _Pragma("unroll") for (int m = 0; m < 4; ++m) _Pragma("unroll") for (int n = 0; n < 2; ++n) _Pragma("unroll") for (int k = 0; k < 2; ++k) \
        acc[ai][bj][m][n] = __builtin_amdgcn_mfma_f32_16x16x32_bf16(Bt[n][k], At[m][k], acc[ai][bj][m][n], 0, 0, 0); __builtin_amdgcn_s_setprio(0); } while (0)
#define PG8_WAIT_V(n) asm volatile("s_waitcnt vmcnt(" #n ")" ::: "memory")
#define PG8_WAIT_L(n) asm volatile("s_waitcnt lgkmcnt(" #n ")" ::: "memory")
#define PG8_BAR __builtin_amdgcn_s_barrier()
#define PG8_SCHED __builtin_amdgcn_sched_barrier(0)
    Unit cur, nxt; int ui = 0;
    if (!S.next(0, cur)) return;
    f32x4 acc[2][2][4][2];
#pragma unroll
    for (int a = 0; a < 2; ++a)
#pragma unroll
        for (int b = 0; b < 2; ++b)
#pragma unroll
            for (int m = 0; m < 4; ++m)
#pragma unroll
                for (int n = 0; n < 2; ++n) acc[a][b][m][n] = (f32x4){0.f, 0.f, 0.f, 0.f};
    bf16x8 At[4][2], B0[2][2], B1[2][2];
    const char* cA = (const char*)g.A + (size_t)cur.pm * tstepA + (size_t)cur.k0 * kstep; const char* cB = (const char*)g.Bt + (size_t)cur.pn * tstepB + (size_t)cur.k0 * kstep;
    PG8_STAGE(PG8_SB(0, 0), cB, voffB); PG8_STAGE(PG8_SB(0, 1), cB + hstepB, voffB); PG8_STAGE(PG8_SA(0, 0), cA, voffA); PG8_STAGE(PG8_SA(0, 1), cA + hstepA, voffA);
    if (wr == 1) PG8_BAR;
    PG8_WAIT_V(2); PG8_BAR;
    PG8_STAGE(PG8_SB(1, 0), cB + kstep, voffB); PG8_STAGE(PG8_SA(1, 0), cA + kstep, voffA); PG8_STAGE(PG8_SB(1, 1), cB + hstepB + kstep, voffB);
    PG8_WAIT_V(6); PG8_BAR;
    for (;;) {
        const bool has_next = S.next(ui + 1, nxt);
        const char* nA = has_next ? (const char*)g.A + (size_t)nxt.pm * tstepA + (size_t)nxt.k0 * kstep : cA; const char* nB = has_next ? (const char*)g.Bt + (size_t)nxt.pn * tstepB + (size_t)nxt.k0 * kstep : cB;
        const int nt = cur.nk;
        for (int t = 0; t < nt; t += 2) {
            const bool last = (t == nt - 2);
            const char* a1 = cA + (size_t)(t + 1) * kstep;
            const char* a2 = last ? nA : cA + (size_t)(t + 2) * kstep; const char* b2 = last ? nB : cB + (size_t)(t + 2) * kstep;
            const char* a3 = a2 + kstep; const char* b3 = b2 + kstep;
            PG8_LDB(B0, 0, 0); PG8_LDB(B1, 0, 1); PG8_SCHED; PG8_LDA(At, 0, 0); PG8_STAGE(PG8_SA(1, 1), a1 + hstepA, voffA);
            PG8_WAIT_V(8); PG8_WAIT_L(0); PG8_BAR; PG8_MMA(0, 0, At, B0); PG8_MMA(0, 1, At, B1); PG8_BAR; PG8_SCHED;
            PG8_LDA(At, 0, 1); PG8_STAGE(PG8_SB(0, 0), b2, voffB); PG8_STAGE(PG8_SB(0, 1), b2 + hstepB, voffB); PG8_STAGE(PG8_SA(0, 0), a2, voffA);
            PG8_WAIT_V(8); PG8_WAIT_L(0); PG8_BAR; PG8_MMA(1, 0, At, B0); PG8_MMA(1, 1, At, B1); PG8_BAR; PG8_SCHED;
            PG8_LDB(B0, 1, 0); PG8_LDB(B1, 1, 1); PG8_SCHED; PG8_LDA(At, 1, 0); PG8_STAGE(PG8_SA(0, 1), a2 + hstepA, voffA);
            PG8_WAIT_V(8); PG8_WAIT_L(0); PG8_BAR; PG8_MMA(0, 0, At, B0); PG8_MMA(0, 1, At, B1); PG8_BAR; PG8_SCHED;
            PG8_LDA(At, 1, 1); PG8_STAGE(PG8_SB(1, 0), b3, voffB); PG8_STAGE(PG8_SB(1, 1), b3 + hstepB, voffB); PG8_STAGE(PG8_SA(1, 0), a3, voffA);
            PG8_WAIT_V(8); PG8_WAIT_L(0); PG8_BAR; PG8_MMA(1, 0, At, B0); PG8_MMA(1, 1, At, B1); PG8_BAR; PG8_SCHED;
        }
        if (wr == 0) PG8_BAR;
        E(acc, cur, wr, wc, fr, fq);
        if (!has_next) break;
#pragma unroll
        for (int a = 0; a < 2; ++a)
#pragma unroll
            for (int b = 0; b < 2; ++b)
#pragma unroll
                for (int m = 0; m < 4; ++m)
#pragma unroll
                    for (int n = 0; n < 2; ++n) acc[a][b][m][n] = (f32x4){0.f, 0.f, 0.f, 0.f};
        cur = nxt; cA = nA; cB = nB; ++ui;
        if (wr == 1) PG8_BAR;
    }
    PG8_WAIT_V(0);
    PG8_BAR;
#undef PG8_SA
#undef PG8_SB
#undef PG8_STAGE
#undef PG8_LDA
#undef PG8_LDB
#undef PG8_MMA
#undef PG8_WAIT_V
#undef PG8_WAIT_L
#undef PG8_BAR
#undef PG8_SCHED
}
}
using pg8::Unit;

struct EpiIn {
    static constexpr bool PERM = true;
    Params p;
    __device__ __forceinline__ void operator()(const f32x4 (&acc)[2][2][4][2], const Unit& u, int wr, int wc, int fr, int fq) const {
        const int pn = u.pn;
        int mode, ld, c0; u16* base;
        if (pn < 4) { mode = 0; base = (u16*)((unsigned char*)p.out + OB_Q); ld = 1024; c0 = pn * 256; }
        else if (pn < 6) { mode = 1; base = (u16*)((unsigned char*)p.out + OB_KV); ld = 512; c0 = (pn - 4) * 256; }
        else { const int g = (pn - 6) >> 2; c0 = ((pn - 6) & 3) * 256; ld = 1024; base = (u16*)(p.ws + W_S1 + (size_t)g * SLOT);
               mode = (g == 1) ? 3 : 4; }
        const float* lb = (const float*)(p.ws + W_LB);
#pragma unroll
        for (int ai = 0; ai < 2; ++ai)
#pragma unroll
            for (int m = 0; m < 4; ++m) {
                const int row = u.pm * 256 + ai * 128 + wr * 64 + m * 16 + fr;
                if (row >= MROWS) continue;
                float* fo = nullptr;
                if (mode == 1) {
                    const size_t sel = (pn == 4) ? 0 : 1;
                    if (row >= ROW_M) fo = p.out + (sel ? O_METAV : O_METAK) + (size_t)(row - ROW_M) * 256;
                    else if (row >= ROW_S) { const int s = row - ROW_S; fo = p.out + (sel ? O_WINVS : O_WINKS) + ((size_t)(s >> 3) * 128 + 120 + (s & 7)) * 256; }
                    else if (row >= NPR - 128) fo = p.out + (sel ? O_WINVP : O_WINKP) + (size_t)(row - (NPR - 128)) * 256;
                }
#pragma unroll
                for (int bj = 0; bj < 2; ++bj) {
                    const int cl = bj * 128 + wc * 32 + 8 * fq;
                    float v[8];
#pragma unroll
                    for (int j = 0; j < 4; ++j) { v[j] = acc[ai][bj][m][0][j]; v[4 + j] = acc[ai][bj][m][1][j]; }
                    if (mode == 0) {
#pragma unroll
                        for (int j = 0; j < 8; ++j) v[j] *= 0.125f;
                    } else if (mode == 1) {
                        if (fo) { *(f32x4*)(fo + cl) = (f32x4){v[0], v[1], v[2], v[3]}; *(f32x4*)(fo + cl + 4) = (f32x4){v[4], v[5], v[6], v[7]}; }
                    } else if (mode == 2) {
#pragma unroll
                        for (int j = 0; j < 8; ++j) v[j] = v[j] * sigmoidf_(v[j]);
                    } else if (mode == 3) {
                        const f32x4 l0 = *(const f32x4*)(lb + c0 + cl), l1 = *(const f32x4*)(lb + c0 + cl + 4);
                        u32x4 w; unsigned hh[8];
#pragma unroll
                        for (int j = 0; j < 8; ++j) { const float l = j < 4 ? l0[j] : l1[j - 4]; const float f = l + (1.0f - l) * sigmoidf_(v[j]); hh[j] = f2h(__logf(f)); }
                        w.x = hh[0] | (hh[1] << 16); w.y = hh[2] | (hh[3] << 16); w.z = hh[4] | (hh[5] << 16); w.w = hh[6] | (hh[7] << 16);
                        *(u32x4*)(base + (size_t)row * ld + c0 + cl) = w;
                        continue;
                    } else if (mode == 5) {
#pragma unroll
                        for (int j = 0; j < 8; ++j) v[j] = sigmoidf_(v[j]);
                    }
                    *(u32x4*)(base + (size_t)row * ld + c0 + cl) = pack8(v);
                }
            }
    }
};
struct EpiRes1 {
    static constexpr bool PERM = true;
    Params p;
    __device__ __forceinline__ void operator()(const f32x4 (&acc)[2][2][4][2], const Unit& u, int wr, int wc, int fr, int fq) const {
#pragma unroll
        for (int ai = 0; ai < 2; ++ai)
#pragma unroll
            for (int m = 0; m < 4; ++m) {
                const int row = u.pm * 256 + ai * 128 + wr * 64 + m * 16 + fr;
                if (row >= MROWS) continue;
                if (u.sl == 1) {
                    float* pr = (float*)(p.ws + W_S2) + (size_t)(row - ROW_S) * DM;
#pragma unroll
                    for (int bj = 0; bj < 2; ++bj) { const int c = u.pn * 256 + bj * 128 + wc * 32 + 8 * fq;
                        *(f32x4*)(pr + c) = acc[ai][bj][m][0]; *(f32x4*)(pr + c + 4) = acc[ai][bj][m][1]; }
                    continue;
                }
                const float* xr = xrow(p, row); u16* yr = (u16*)(p.ws + W_S1) + (size_t)row * DM;
#pragma unroll
                for (int bj = 0; bj < 2; ++bj) {
                    const int c = u.pn * 256 + bj * 128 + wc * 32 + 8 * fq;
                    const f32x4 x0 = __builtin_nontemporal_load((const f32x4*)(xr + c)), x1 = __builtin_nontemporal_load((const f32x4*)(xr + c + 4));
                    const f32x4 y0 = x0 * ALPHA + acc[ai][bj][m][0], y1 = x1 * ALPHA + acc[ai][bj][m][1];
                    u32x4 w; w.x = cvt_pk_bf16(y0[0], y0[1]); w.y = cvt_pk_bf16(y0[2], y0[3]); w.z = cvt_pk_bf16(y1[0], y1[1]); w.w = cvt_pk_bf16(y1[2], y1[3]);
                    *(u32x4*)(yr + c) = w;
                }
            }
    }
};
struct EpiRes2 {
    static constexpr bool PERM = true;
    Params p;
    __device__ __forceinline__ void operator()(const f32x4 (&acc)[2][2][4][2], const Unit& u, int wr, int wc, int fr, int fq) const {
#pragma unroll
        for (int ai = 0; ai < 2; ++ai)
#pragma unroll
            for (int m = 0; m < 4; ++m) {
                const int row = u.pm * 256 + ai * 128 + wr * 64 + m * 16 + fr;
                if (u.sl >= 0) {
                    float* pr = part_row(p.ws, u.sl, row - ROW_S);
#pragma unroll
                    for (int bj = 0; bj < 2; ++bj) { const int c = u.pn * 256 + bj * 128 + wc * 32 + 8 * fq;
                        *(f32x4*)(pr + c) = acc[ai][bj][m][0]; *(f32x4*)(pr + c + 4) = acc[ai][bj][m][1]; }
                    continue;
                }
                u16* xr = (u16*)(p.ws + W_S1) + (size_t)row * DM;
#pragma unroll
                for (int bj = 0; bj < 2; ++bj) {
                    const int c = u.pn * 256 + bj * 128 + wc * 32 + 8 * fq;
                    const u32x4 xw = *(const u32x4*)(xr + c);
                    const f32x4 x0 = {bflo(xw.x), bfhi(xw.x), bflo(xw.y), bfhi(xw.y)}, x1 = {bflo(xw.z), bfhi(xw.z), bflo(xw.w), bfhi(xw.w)};
                    const f32x4 y0 = x0 * ALPHA + acc[ai][bj][m][0], y1 = x1 * ALPHA + acc[ai][bj][m][1];
                    u32x4 w; w.x = cvt_pk_bf16(y0[0], y0[1]); w.y = cvt_pk_bf16(y0[2], y0[3]); w.z = cvt_pk_bf16(y1[0], y1[1]); w.w = cvt_pk_bf16(y1[2], y1[3]);
                    *(u32x4*)(xr + c) = w;
                }
            }
    }
};
__device__ __forceinline__ float dpp_f(float oldv, float src, const int ctrl_sel) {
    const int o = __builtin_bit_cast(int, oldv), sv = __builtin_bit_cast(int, src); int r;
    if (ctrl_sel == 0) r = __builtin_amdgcn_update_dpp(o, sv, 0x121, 0xF, 0xF, false);
    else if (ctrl_sel == 1) r = __builtin_amdgcn_update_dpp(o, sv, 0x122, 0xF, 0xF, false);
    else if (ctrl_sel == 2) r = __builtin_amdgcn_update_dpp(o, sv, 0x111, 0xF, 0xF, false);
    else r = __builtin_amdgcn_update_dpp(o, sv, 0x112, 0xF, 0xF, false);
    return __builtin_bit_cast(float, r);
}
__device__ __forceinline__ float gelu_tanh_f(float x) {
    const float z = 0.7978845608028654f * (x + 0.044715f * x * x * x);
    const float th = 1.0f - 2.0f * __builtin_amdgcn_rcpf(1.0f + __expf(2.0f * z));
    return 0.5f * x * (1.0f + th);
}
struct EpiUp {
    static constexpr bool PERM = true;
    Params p; LAS float* xch;
    __device__ __forceinline__ void operator()(const f32x4 (&acc)[2][2][4][2], const Unit& u, int wr, int wc, int fr, int fq) const {
        u16* UV = (u16*)(p.ws + W_UV);
        const float* cw = p.in[17]; const float* cb = p.in[18]; const float* sc = p.in[7];
        const int ch0 = u.pn * 128 + wc * 32 + 8 * fq;
        if (fr >= 14) {
#pragma unroll
            for (int ai = 0; ai < 2; ++ai) { LAS float* d = xch + ((((ai * 2 + wr) * 4 + wc) * 2 + (fr & 1)) * 4 + fq) * 8;
                *(LAS f32x4*)d = acc[ai][0][3][0]; *(LAS f32x4*)(d + 4) = acc[ai][0][3][1]; }
        }
        asm volatile("s_waitcnt lgkmcnt(0)" ::: "memory");
        __builtin_amdgcn_s_barrier();
        const bool sample_tile = (u.pm >= 64 && u.pm < 68);
#pragma unroll
        for (int ai = 0; ai < 2; ++ai) {
            f32x4 pv0 = {0.f, 0.f, 0.f, 0.f}, pv1 = pv0;
            if (wr == 1 || ai == 1) { const int pa = (wr == 1) ? ai : 0, pw = (wr == 1) ? 0 : 1;
                LAS const float* d = xch + ((((pa * 2 + pw) * 4 + wc) * 2 + (fr & 1)) * 4 + fq) * 8; pv0 = *(LAS const f32x4*)d; pv1 = *(LAS const f32x4*)(d + 4); }
#pragma unroll
            for (int m = 0; m < 4; ++m) {
                const int row = u.pm * 256 + ai * 128 + wr * 64 + m * 16 + fr;
                float uu[8], vv[8], pp[8], u1[8], u2[8];
#pragma unroll
                for (int j = 0; j < 4; ++j) { uu[j] = acc[ai][0][m][0][j]; uu[4 + j] = acc[ai][0][m][1][j]; vv[j] = acc[ai][1][m][0][j]; vv[4 + j] = acc[ai][1][m][1][j];
                    pp[j] = (m == 0) ? pv0[j] : acc[ai][0][m > 0 ? m - 1 : 0][0][j]; pp[4 + j] = (m == 0) ? pv1[j] : acc[ai][0][m > 0 ? m - 1 : 0][1][j]; }
#pragma unroll
                for (int e = 0; e < 8; ++e) { u1[e] = dpp_f(dpp_f(0.f, pp[e], 0), uu[e], 2); u2[e] = dpp_f(dpp_f(0.f, pp[e], 1), uu[e], 3); }
                if (sample_tile) {
                    const int j8 = fr & 7, b = (row - ROW_S) >> 3;
                    if (j8 < 2) { const float* s1 = sc + ((size_t)b * 2 + 1) * DFF + ch0; const f32x4 a = *(const f32x4*)s1, c4 = *(const f32x4*)(s1 + 4);
                        if (j8 == 0) { const float* s0 = sc + ((size_t)b * 2) * DFF + ch0; const f32x4 a0 = *(const f32x4*)s0, c0 = *(const f32x4*)(s0 + 4);
#pragma unroll
                            for (int j = 0; j < 4; ++j) { u1[j] = a[j]; u1[4 + j] = c4[j]; u2[j] = a0[j]; u2[4 + j] = c0[j]; } }
                        else {
#pragma unroll
                            for (int j = 0; j < 4; ++j) { u2[j] = a[j]; u2[4 + j] = c4[j]; } } }
                }
                if (row < MROWS) {
                    const f32x4 w0a = *(const f32x4*)(cw + ch0), w0b = *(const f32x4*)(cw + ch0 + 4), w1a = *(const f32x4*)(cw + DFF + ch0), w1b = *(const f32x4*)(cw + DFF + ch0 + 4),
                                w2a = *(const f32x4*)(cw + 2 * DFF + ch0), w2b = *(const f32x4*)(cw + 2 * DFF + ch0 + 4), ba = *(const f32x4*)(cb + ch0), bb = *(const f32x4*)(cb + ch0 + 4);
                    float hv[8];
#pragma unroll
                    for (int e = 0; e < 8; ++e) { const float w0 = e < 4 ? w0a[e & 3] : w0b[e & 3], w1 = e < 4 ? w1a[e & 3] : w1b[e & 3], w2 = e < 4 ? w2a[e & 3] : w2b[e & 3], b0 = e < 4 ? ba[e & 3] : bb[e & 3];
                        hv[e] = gelu_tanh_f(b0 + w0 * u2[e] + w1 * u1[e] + w2 * uu[e]) * vv[e]; }
                    *(u32x4*)(UV + (size_t)row * UVW + DFF + ch0) = pack8(hv);
                    float* fo = nullptr;
                    if (row >= ROW_S && row < ROW_M) { const int s2 = row - ROW_S; if ((s2 & 7) >= 6) fo = p.out + O_CONVS + ((size_t)(s2 >> 3) * 2 + ((s2 & 7) - 6)) * DFF; }
                    else if (row >= NPR - 2 && row < NPR) fo = p.out + O_CONVP + (size_t)(row - (NPR - 2)) * DFF;
                    if (fo) { *(f32x4*)(fo + ch0) = acc[ai][0][m][0]; *(f32x4*)(fo + ch0 + 4) = acc[ai][0][m][1]; }
                    if (ai == 1 && wr == 1 && m == 3 && fr >= 14 && u.pm < 64) *(u32x4*)((u16*)(p.ws + W_HALO) + ((size_t)u.pm * 2 + (fr & 1)) * DFF + ch0) = pack8(uu);
                    if (ai == 0 && wr == 0 && m == 0) {
                        if (u.pm == 68 && fr >= 14) *(u32x4*)((u16*)(p.ws + W_HALO) + ((size_t)69 * 2 + (fr & 1)) * DFF + ch0) = pack8(uu);
                        if (u.pm < 64 && fr < 2) { *(u32x4*)((u16*)(p.ws + W_FIXU) + ((size_t)u.pm * 2 + fr) * DFF + ch0) = pack8(uu); *(u32x4*)((u16*)(p.ws + W_FIXV) + ((size_t)u.pm * 2 + fr) * DFF + ch0) = pack8(vv); }
                    }
                }
            }
        }
    }
};

__device__ __forceinline__ void meta_inproj(const Params& p, int bid, int w, int lane, int G) {
    const int fr = lane & 15, fq = lane >> 4;
    const u16* Xb = (const u16*)((const unsigned char*)p.out + OB_XB) + (size_t)(ROW_M + fr) * DM + fq * 8;
    const float* lb = (const float*)(p.ws + W_LB);
    for (int tile = w * G + bid; tile < INC / 16; tile += 8 * G) {
        const u16* Wr = (const u16*)(p.ws + W_WIN) + (size_t)(tile * 16 + fr) * DM + fq * 8;
        f32x4 a = {0.f, 0.f, 0.f, 0.f};
#pragma unroll 8
        for (int ks = 0; ks < 32; ++ks) {
            const bf16x8 bw = *(const bf16x8*)(Wr + ks * 32), ax = *(const bf16x8*)(Xb + ks * 32);
            a = __builtin_amdgcn_mfma_f32_16x16x32_bf16(bw, ax, a, 0, 0, 0);
        }
        const int col = tile * 16 + fq * 4, row = ROW_M + fr;
        float v[4] = {a[0], a[1], a[2], a[3]};
        u16* dst;
        if (col < 1024) { dst = (u16*)((unsigned char*)p.out + OB_Q) + (size_t)row * 1024 + col;
#pragma unroll
            for (int j = 0; j < 4; ++j) v[j] *= 0.125f; }
        else if (col < 1536) { dst = (u16*)((unsigned char*)p.out + OB_KV) + (size_t)row * 512 + (col - 1024);
            float* fo = p.out + (col < 1280 ? O_METAK : O_METAV) + (size_t)fr * 256 + (col & 255);
            *(f32x4*)fo = (f32x4){v[0], v[1], v[2], v[3]}; }
        else { const int g = (col - 1536) >> 10, c = (col - 1536) & 1023; dst = (u16*)(p.ws + W_S1 + (size_t)g * SLOT) + (size_t)row * 1024 + c;
            if (g == 1) { const f32x4 l4 = *(const f32x4*)(lb + c); unsigned hh[4];
#pragma unroll
                for (int j = 0; j < 4; ++j) { const float f = l4[j] + (1.0f - l4[j]) * sigmoidf_(v[j]); hh[j] = f2h(__logf(f)); }
                u32x2 wv; wv.x = hh[0] | (hh[1] << 16); wv.y = hh[2] | (hh[3] << 16); *(u32x2*)dst = wv; continue; } }
        u32x2 wv; wv.x = cvt_pk_bf16(v[0], v[1]); wv.y = cvt_pk_bf16(v[2], v[3]); *(u32x2*)dst = wv;
    }
}

__device__ __forceinline__ void transpose_tile(const float* W, int K, int N, u16* Wt, int tile, LAS float* sm, bool perm_up = false) {
    const int ntn = N / 64, tk = tile / ntn, tn = tile % ntn, tid = threadIdx.x;
    const int n0 = tn * 64, ch0 = n0 % DFF, nout = perm_up ? (ch0 / 128) * 256 + (ch0 % 128) + (n0 >= DFF ? 128 : 0) : n0;
#pragma unroll
    for (int i = 0; i < 8; ++i) { const int k = i * 8 + (tid >> 6), n = tid & 63; sm[k * 65 + n] = W[(size_t)(tk * 64 + k) * N + tn * 64 + n]; }
    __syncthreads();
    { const int n = tid >> 3, kg = tid & 7; float v[8];
#pragma unroll
      for (int j = 0; j < 8; ++j) v[j] = sm[(kg * 8 + j) * 65 + n];
      *(u32x4*)(Wt + (size_t)(nout + n) * K + tk * 64 + kg * 8) = pack8(v); }
    __syncthreads();
}

struct TDesc { const float* W; u16* Wt; int K, N, tile; bool perm, valid; };
__device__ __forceinline__ void transpose4(const TDesc (&d)[4], LAS float* sm) {
    const int tid = threadIdx.x;
    float r[4][8];
#pragma unroll
    for (int q = 0; q < 4; ++q) if (d[q].valid) { const int ntn = d[q].N / 64, tk = d[q].tile / ntn, tn = d[q].tile % ntn;
#pragma unroll
        for (int i = 0; i < 8; ++i) r[q][i] = __builtin_nontemporal_load(d[q].W + (size_t)(tk * 64 + i * 8 + (tid >> 6)) * d[q].N + tn * 64 + (tid & 63)); }
#pragma unroll
    for (int q = 0; q < 4; ++q) if (d[q].valid) {
#pragma unroll
        for (int i = 0; i < 8; ++i) sm[q * 4160 + (i * 8 + (tid >> 6)) * 65 + (tid & 63)] = r[q][i]; }
    __syncthreads();
#pragma unroll
    for (int q = 0; q < 4; ++q) if (d[q].valid) { const int ntn = d[q].N / 64, tk = d[q].tile / ntn, tn = d[q].tile % ntn;
        const int n0 = tn * 64, ch0 = n0 % DFF, nout = d[q].perm ? (ch0 / 128) * 256 + (ch0 % 128) + (n0 >= DFF ? 128 : 0) : n0;
        const int n = tid >> 3, kg = tid & 7; float v[8];
#pragma unroll
        for (int j = 0; j < 8; ++j) v[j] = sm[q * 4160 + (kg * 8 + j) * 65 + n];
        *(u32x4*)(d[q].Wt + (size_t)(nout + n) * d[q].K + tk * 64 + kg * 8) = pack8(v); }
    __syncthreads();
}

constexpr int KS_LD = 72, VT_LD = 296, NSLOT = 288;
constexpr int ATT_KS = 0, ATT_VT = NSLOT * KS_LD * 2, ATT_P = ATT_VT + 64 * VT_LD * 2;
static_assert(ATT_P + 8 * 16 * VT_LD * 2 <= LDS_BYTES, "attention LDS");

__device__ __forceinline__ void attn_rowtile(LAS const u16* Ks, LAS const u16* Vt, LAS u16* Pw, const u16* qptr, u16* optr,
                                             int tq, int meta_lim, int bs_min, int bs_max, int kk1, float sink, int lane) {
    const int fr = lane & 15, fq = lane >> 4;
    bf16x8 qf0 = *(const bf16x8*)(qptr + fq * 8), qf1 = *(const bf16x8*)(qptr + 32 + fq * 8);
    f32x4 s[12];
#pragma unroll
    for (int i = 0; i < 12; ++i) {
        const int tile = (i < 2) ? i : 2 * kk1 + (i - 2);
        LAS const u16* kr = Ks + (tile * 16 + fr) * KS_LD + fq * 8;
        const bf16x8 k0 = *(LAS const bf16x8*)kr, k1 = *(LAS const bf16x8*)(kr + 32);
        f32x4 a = {0.f, 0.f, 0.f, 0.f};
        a = __builtin_amdgcn_mfma_f32_16x16x32_bf16(k0, qf0, a, 0, 0, 0);
        a = __builtin_amdgcn_mfma_f32_16x16x32_bf16(k1, qf1, a, 0, 0, 0);
        s[i] = a;
    }
    float mx = sink;
#pragma unroll
    for (int i = 0; i < 12; ++i) {
        const int tile = (i < 2) ? i : 2 * kk1 + (i - 2);
#pragma unroll
        for (int jj = 0; jj < 4; ++jj) {
            const int slot = tile * 16 + fq * 4 + jj, bs = slot - 16;
            const bool vis = (slot < 16) ? (slot <= meta_lim) : (bs > tq && bs <= tq + 128 && bs >= bs_min && bs < bs_max);
            const float v = vis ? s[i][jj] : -1e30f; s[i][jj] = v; mx = fmaxf(mx, v);
        }
    }
    mx = fmaxf(mx, __shfl_xor(mx, 16)); mx = fmaxf(mx, __shfl_xor(mx, 32));
    float sum = 0.f;
#pragma unroll
    for (int i = 0; i < 12; ++i) {
        const int tile = (i < 2) ? i : 2 * kk1 + (i - 2);
        float pv[4];
#pragma unroll
        for (int jj = 0; jj < 4; ++jj) { pv[jj] = __expf(s[i][jj] - mx); sum += pv[jj]; }
        u32x2 w; w.x = cvt_pk_bf16(pv[0], pv[1]); w.y = cvt_pk_bf16(pv[2], pv[3]);
        *(LAS u32x2*)(Pw + fr * VT_LD + tile * 16 + fq * 4) = w;
    }
    sum += __shfl_xor(sum, 16); sum += __shfl_xor(sum, 32);
    const float inv = __builtin_amdgcn_rcpf(sum + __expf(sink - mx));
    asm volatile("s_waitcnt lgkmcnt(0)" ::: "memory"); __builtin_amdgcn_wave_barrier();
    f32x4 o[4];
#pragma unroll
    for (int dt = 0; dt < 4; ++dt) o[dt] = (f32x4){0.f, 0.f, 0.f, 0.f};
#pragma unroll
    for (int ks = 0; ks < 6; ++ks) {
        const int kk = (ks == 0) ? 0 : kk1 + ks - 1;
        const bf16x8 pf = *(LAS const bf16x8*)(Pw + fr * VT_LD + kk * 32 + fq * 8);
#pragma unroll
        for (int dt = 0; dt < 4; ++dt) {
            const bf16x8 vf = *(LAS const bf16x8*)(Vt + (dt * 16 + fr) * VT_LD + kk * 32 + fq * 8);
            o[dt] = __builtin_amdgcn_mfma_f32_16x16x32_bf16(vf, pf, o[dt], 0, 0, 0);
        }
    }
#pragma unroll
    for (int dt = 0; dt < 4; ++dt) {
        u32x2 w; w.x = cvt_pk_bf16(o[dt][0] * inv, o[dt][1] * inv); w.y = cvt_pk_bf16(o[dt][2] * inv, o[dt][3] * inv);
        *(u32x2*)(optr + dt * 16 + fq * 4) = w;
    }
    asm volatile("s_waitcnt lgkmcnt(0)" ::: "memory"); __builtin_amdgcn_wave_barrier();
}

__device__ __forceinline__ u32x4 kv_load8(const Params& p, int mode, int nb, int kvh, int slot, int dg, int isV) {
    const u16* KV = (const u16*)((const unsigned char*)p.out + OB_KV);
    const u32x4 z = {0u, 0u, 0u, 0u};
    if (mode == 0) {
        int row;
        if (slot < 16) row = ROW_M + slot;
        else if (slot < 272) { row = 128 * (nb - 2) + (slot - 16); if (nb < 1 || row < 0) return z; }
        else return z;
        return *(const u32x4*)(KV + (size_t)row * 512 + isV * 256 + kvh * 64 + dg * 8);
    } else {
        if (slot < 144) {
            const float* src = (slot < 16) ? p.in[2 + isV] + ((size_t)(nb * 16 + slot) * 4 + kvh) * 64 + dg * 8
                                           : p.in[4 + isV] + ((size_t)(nb * 128 + slot - 16) * 4 + kvh) * 64 + dg * 8;
            const f32x4 a = __builtin_nontemporal_load((const f32x4*)src), b = __builtin_nontemporal_load((const f32x4*)(src + 4));
            u32x4 w; w.x = cvt_pk_bf16(a[0], a[1]); w.y = cvt_pk_bf16(a[2], a[3]); w.z = cvt_pk_bf16(b[0], b[1]); w.w = cvt_pk_bf16(b[2], b[3]); return w;
        } else if (slot < 152) {
            return *(const u32x4*)(KV + (size_t)(ROW_S + nb * 8 + slot - 144) * 512 + isV * 256 + kvh * 64 + dg * 8);
        }
        return z;
    }
}

__device__ __forceinline__ void attn_load(const Params& p, int mode, int nb, int kvh, int nslots, u32x4 (&k)[5], u32x4 (&va)[3], u32x4 (&vb)[3]) {
    const int tid = threadIdx.x, np = nslots >> 1;
#pragma unroll
    for (int i = 0; i < 5; ++i) { const int c = tid + i * 512; if (c < nslots * 8) k[i] = kv_load8(p, mode, nb, kvh, c >> 3, c & 7, 0); }
#pragma unroll
    for (int i = 0; i < 3; ++i) { const int c = tid + i * 512; if (c < np * 8) { const int pr = c % np, dg = c / np;
        va[i] = kv_load8(p, mode, nb, kvh, 2 * pr, dg, 1); vb[i] = kv_load8(p, mode, nb, kvh, 2 * pr + 1, dg, 1); } }
}
__device__ __forceinline__ void attn_store(LAS unsigned char* lds, int nslots, const u32x4 (&k)[5], const u32x4 (&va)[3], const u32x4 (&vb)[3]) {
    LAS u16* Ks = (LAS u16*)(lds + ATT_KS); LAS u16* Vt = (LAS u16*)(lds + ATT_VT);
    const int tid = threadIdx.x, np = nslots >> 1;
#pragma unroll
    for (int i = 0; i < 5; ++i) { const int c = tid + i * 512; if (c < nslots * 8) *(LAS u32x4*)(Ks + (c >> 3) * KS_LD + (c & 7) * 8) = k[i]; }
#pragma unroll
    for (int i = 0; i < 3; ++i) { const int c = tid + i * 512; if (c < np * 8) { const int pr = c % np, dg = c / np;
        const u32x4 a = va[i], b = vb[i];
        LAS u16* d = Vt + (dg * 8) * VT_LD + 2 * pr;
        *(LAS unsigned*)(d + 0 * VT_LD) = (a.x & 0xffffu) | (b.x << 16);  *(LAS unsigned*)(d + 1 * VT_LD) = (a.x >> 16) | (b.x & 0xffff0000u);
        *(LAS unsigned*)(d + 2 * VT_LD) = (a.y & 0xffffu) | (b.y << 16);  *(LAS unsigned*)(d + 3 * VT_LD) = (a.y >> 16) | (b.y & 0xffff0000u);
        *(LAS unsigned*)(d + 4 * VT_LD) = (a.z & 0xffffu) | (b.z << 16);  *(LAS unsigned*)(d + 5 * VT_LD) = (a.z >> 16) | (b.z & 0xffff0000u);
        *(LAS unsigned*)(d + 6 * VT_LD) = (a.w & 0xffffu) | (b.w << 16);  *(LAS unsigned*)(d + 7 * VT_LD) = (a.w >> 16) | (b.w & 0xffff0000u); } }
}

__device__ __forceinline__ void attn_prompt_items(const Params& p, LAS unsigned char* lds, int bid, int G) {
    const int tid = threadIdx.x, lane = tid & 63, w = __builtin_amdgcn_readfirstlane(tid >> 6), fr = lane & 15;
    LAS const u16* Ks = (LAS const u16*)(lds + ATT_KS); LAS const u16* Vt = (LAS const u16*)(lds + ATT_VT);
    LAS u16* Pw = (LAS u16*)(lds + ATT_P) + w * 16 * VT_LD;
    u16* Q = (u16*)((unsigned char*)p.out + OB_Q);
    u32x4 k[5], va[3], vb[3];
    int it = bid;
    if (it >= 516) return;
    { const int nb = (it < 512) ? 1 + (it >> 2) : 0; attn_load(p, 0, nb, it & 3, nb == 0 ? 192 : NSLOT, k, va, vb); }
    for (; it < 516; it += G) {
        const int nb = (it < 512) ? 1 + (it >> 2) : 0, kvh = it & 3;
        attn_store(lds, nb == 0 ? 192 : NSLOT, k, va, vb);
        __syncthreads();
        { const int nx = it + G; if (nx < 516) { const int nb2 = (nx < 512) ? 1 + (nx >> 2) : 0; attn_load(p, 0, nb2, nx & 3, nb2 == 0 ? 192 : NSLOT, k, va, vb); } }
        if (nb > 0) {
            const int ts = w, tq = ts * 16 + fr, row = 128 * (nb - 1) + tq, kk1 = max(1, (1 + ts) >> 1);
            for (int gq = 0; gq < 4; ++gq) {
                const int head = kvh * 4 + gq;
                u16* qp = Q + (size_t)row * DM + head * 64;
                attn_rowtile(Ks, Vt, Pw, qp, qp, tq, 15, nb >= 2 ? 0 : 128, 256, kk1, p.in[10][head], lane);
            }
        } else if (w < 4) {
            const int head = kvh * 4 + w;
            u16* qp = Q + (size_t)(ROW_M + fr) * DM + head * 64;
            attn_rowtile(Ks, Vt, Pw, qp, qp, fr, fr, 128, 0, 1, p.in[10][head], lane);
        }
        __syncthreads();
    }
}
__device__ __forceinline__ void attn_sample_items(const Params& p, LAS unsigned char* lds, int bid, int G) {
    const int tid = threadIdx.x, lane = tid & 63, w = __builtin_amdgcn_readfirstlane(tid >> 6), fr = lane & 15;
    LAS const u16* Ks = (LAS const u16*)(lds + ATT_KS); LAS const u16* Vt = (LAS const u16*)(lds + ATT_VT);
    LAS u16* Pw = (LAS u16*)(lds + ATT_P) + w * 16 * VT_LD;
    u16* Q = (u16*)((unsigned char*)p.out + OB_Q);
    u32x4 k[5], va[3], vb[3];
    int it = bid;
    if (it >= 512) return;
    attn_load(p, 1, it >> 2, it & 3, 192, k, va, vb);
    for (; it < 512; it += G) {
        const int b = it >> 2, kvh = it & 3;
        attn_store(lds, 192, k, va, vb);
        __syncthreads();
        { const int nx = it + G; if (nx < 512) attn_load(p, 1, nx >> 2, nx & 3, 192, k, va, vb); }
        if (w < 2) {
            const int head = kvh * 4 + w * 2 + (fr >> 3), j = fr & 7;
            u16* qp = Q + (size_t)(ROW_S + b * 8 + j) * DM + head * 64;
            attn_rowtile(Ks, Vt, Pw, qp, qp, j, 15, 0, 136, 1, p.in[10][head], lane);
        }
        __syncthreads();
    }
}

constexpr int HQ_LD = 136, HK_LD = 72;
constexpr int H_QD = 0, H_KD = H_QD + 64 * HQ_LD * 2, H_KE = H_KD + 64 * HQ_LD * 2, H_VT = H_KE + 128 * HK_LD * 2, H_PM = H_VT + 128 * HK_LD * 2,
              H_ST = H_PM + 64 * HK_LD * 2, H_SEG = H_ST + 128 * HQ_LD * 2, H_DEC = H_SEG + 4096, H_LF = H_DEC + 512, H_END = H_LF + 64 * 128 * 4;
constexpr int H_VR = H_ST;
static_assert(H_END <= LDS_BYTES - 16, "hgrn LDS");

template <bool L3>
__device__ __forceinline__ void hgrn_prompt_item(const Params& p, LAS unsigned char* lds, int g, int h) {
    const int tid = threadIdx.x, lane = tid & 63, w = __builtin_amdgcn_readfirstlane(tid >> 6), fr = lane & 15, fq = lane >> 4;
    LAS u16* QD = (LAS u16*)(lds + H_QD); LAS u16* KD = (LAS u16*)(lds + H_KD); LAS u16* KEt = (LAS u16*)(lds + H_KE); LAS u16* Vt = (LAS u16*)(lds + H_VT);
    LAS u16* Pm = (LAS u16*)(lds + H_PM); LAS u16* St = (LAS u16*)(lds + H_ST); LAS float* segt = (LAS float*)(lds + H_SEG); LAS float* decs = (LAS float*)(lds + H_DEC);
    u16* HQ = (u16*)(p.ws + W_S1); const u16* LF = (const u16*)(p.ws + W_S2); const u16* HV = (const u16*)(p.ws + W_S3);
    float* Lb = (float*)(p.ws + W_L); float* Dg = (float*)(p.ws + W_DG);
    f32x4 S[8];
#pragma unroll
    for (int it = 0; it < 8; ++it) S[it] = (f32x4){0.f, 0.f, 0.f, 0.f};
    float gsum0 = 0.f, gsum1 = 0.f;
    if (L3) {
        const float* Lp = Lb + ((size_t)((g * 8 + h) * 8 + w) * 8) * 256;
#pragma unroll
        for (int it = 0; it < 8; ++it) S[it] = *(const f32x4*)(Lp + (it * 64 + lane) * 4);
    }
    LAS float* lfS = (LAS float*)(lds + H_LF); LAS u16* Vraw = (LAS u16*)(lds + H_VR);
    const int nchunks = (g == 0) ? 9 : 8;
#define HG_CHUNK_ROWS(ci_, r0_, nv_) do { if (g == 0) { if ((ci_) == 0) { r0_ = ROW_M; nv_ = 16; } else { r0_ = ((ci_) - 1) * 64; nv_ = 64; } } else { r0_ = g * 512 + (ci_) * 64; nv_ = 64; } } while (0)
    u32x4 pLF[2], pHV[2], pHQ[2];
#define HG_PREFETCH(ci_) do { int r0n_, nvn_; HG_CHUNK_ROWS(ci_, r0n_, nvn_); _Pragma("unroll") for (int rep = 0; rep < 2; ++rep) { \
        const int t_ = (tid >> 4) + rep * 32, c8_ = (tid & 15) * 8; const bool ok_ = t_ < nvn_; const size_t ga_ = (size_t)(r0n_ + t_) * DM + h * 128 + c8_; \
        const u32x4 z4_ = {0u, 0u, 0u, 0u}; pLF[rep] = ok_ ? *(const u32x4*)(LF + ga_) : z4_; pHV[rep] = ok_ ? *(const u32x4*)(HV + ga_) : z4_; \
        if (L3) pHQ[rep] = ok_ ? *(const u32x4*)(HQ + ga_) : z4_; } } while (0)
    HG_PREFETCH(0);
    for (int ci = 0; ci < nchunks; ++ci) {
        int r0, nvalid;
        HG_CHUNK_ROWS(ci, r0, nvalid);
#pragma unroll
        for (int rep = 0; rep < 2; ++rep) {
            const int t = (tid >> 4) + rep * 32, c8 = (tid & 15) * 8;
            const u32x4 lw = pLF[rep];
            f32x4 l0, l1;
            l0[0] = h2f((u16)(lw.x & 0xffffu)); l0[1] = h2f((u16)(lw.x >> 16)); l0[2] = h2f((u16)(lw.y & 0xffffu)); l0[3] = h2f((u16)(lw.y >> 16));
            l1[0] = h2f((u16)(lw.z & 0xffffu)); l1[1] = h2f((u16)(lw.z >> 16)); l1[2] = h2f((u16)(lw.w & 0xffffu)); l1[3] = h2f((u16)(lw.w >> 16));
            *(LAS f32x4*)(lfS + t * 128 + c8) = l0; *(LAS f32x4*)(lfS + t * 128 + c8 + 4) = l1;
            *(LAS u32x4*)(Vraw + t * 128 + c8) = pHV[rep];
            if (L3) *(LAS u32x4*)(QD + t * HQ_LD + c8) = pHQ[rep];
        }
        if (ci + 1 < nchunks) HG_PREFETCH(ci + 1);
        __syncthreads();
        {
            typedef float f32x2v __attribute__((ext_vector_type(2)));
            const int dk0 = (tid & 63) * 2, seg = tid >> 6;
            float lf0[8], lf1[8]; float run0 = 0.f, run1 = 0.f;
#pragma unroll
            for (int i = 0; i < 8; ++i) { const f32x2v l = *(LAS const f32x2v*)(lfS + (seg * 8 + i) * 128 + dk0); lf0[i] = l.x; lf1[i] = l.y; run0 += l.x; run1 += l.y; }
            *(LAS f32x2v*)(segt + seg * 128 + dk0) = (f32x2v){run0, run1};
            __syncthreads();
            float off0 = 0.f, off1 = 0.f, tot0 = 0.f, tot1 = 0.f;
#pragma unroll
            for (int s2 = 0; s2 < 8; ++s2) { const f32x2v v = *(LAS const f32x2v*)(segt + s2 * 128 + dk0); tot0 += v.x; tot1 += v.y; off0 += (s2 < seg) ? v.x : 0.f; off1 += (s2 < seg) ? v.y : 0.f; }
            gsum0 += tot0; gsum1 += tot1;
            if (seg == 0) *(LAS f32x2v*)(decs + dk0) = (f32x2v){__expf(tot0), __expf(tot1)};
            float b0 = off0, b1 = off1; unsigned ke0[4], ke1[4], vv0[4], vv1[4];
#pragma unroll
            for (int i = 0; i < 8; ++i) {
                const int t = seg * 8 + i; const bool ok = t < nvalid;
                b0 += lf0[i]; b1 += lf1[i];
                const float k0 = ok ? 1.0f - __expf(lf0[i]) : 0.f, k1 = ok ? 1.0f - __expf(lf1[i]) : 0.f;
                const unsigned e0 = f2bf(k0 * __expf(tot0 - b0)), e1 = f2bf(k1 * __expf(tot1 - b1));
                const unsigned vw = *(LAS const unsigned*)(Vraw + t * 128 + dk0);
                if (i & 1) { ke0[i >> 1] |= e0 << 16; ke1[i >> 1] |= e1 << 16; vv0[i >> 1] |= vw << 16; vv1[i >> 1] |= vw & 0xffff0000u; }
                else { ke0[i >> 1] = e0; ke1[i >> 1] = e1; vv0[i >> 1] = vw & 0xffffu; vv1[i >> 1] = vw >> 16; }
                if (L3) {
                    *(LAS unsigned*)(KD + t * HQ_LD + dk0) = cvt_pk_bf16(k0 * __expf(-b0), k1 * __expf(-b1));
                    const unsigned qw = *(LAS const unsigned*)(QD + t * HQ_LD + dk0);
                    const float q0 = bflo(qw), q1 = bfhi(qw);
                    *(LAS unsigned*)(QD + t * HQ_LD + dk0) = cvt_pk_bf16(q0 * sigmoidf_(q0) * __expf(b0), q1 * sigmoidf_(q1) * __expf(b1));
                }
            }
            *(LAS u32x4*)(KEt + dk0 * HK_LD + seg * 8) = (u32x4){ke0[0], ke0[1], ke0[2], ke0[3]};
            *(LAS u32x4*)(KEt + (dk0 + 1) * HK_LD + seg * 8) = (u32x4){ke1[0], ke1[1], ke1[2], ke1[3]};
            *(LAS u32x4*)(Vt + dk0 * HK_LD + seg * 8) = (u32x4){vv0[0], vv0[1], vv0[2], vv0[3]};
            *(LAS u32x4*)(Vt + (dk0 + 1) * HK_LD + seg * 8) = (u32x4){vv1[0], vv1[1], vv1[2], vv1[3]};
        }
        __syncthreads();
        bf16x8 vf[2];
#pragma unroll
        for (int ks = 0; ks < 2; ++ks) vf[ks] = *(LAS const bf16x8*)(Vt + (w * 16 + fr) * HK_LD + ks * 32 + fq * 8);
        if (L3) {
            const int tt = w >> 1;
#pragma unroll
            for (int si = 0; si < 2; ++si) {
                const int st = 2 * (w & 1) + si;
                f32x4 a = {0.f, 0.f, 0.f, 0.f};
                if (st <= tt) {
#pragma unroll
                    for (int ks = 0; ks < 4; ++ks) {
                        const bf16x8 kf = *(LAS const bf16x8*)(KD + (st * 16 + fr) * HQ_LD + ks * 32 + fq * 8);
                        const bf16x8 qf = *(LAS const bf16x8*)(QD + (tt * 16 + fr) * HQ_LD + ks * 32 + fq * 8);
                        a = __builtin_amdgcn_mfma_f32_16x16x32_bf16(kf, qf, a, 0, 0, 0);
                    }
                }
                const int t = tt * 16 + fr, s0 = st * 16 + fq * 4;
                u32x2 wv; wv.x = cvt_pk_bf16(s0 <= t ? a[0] : 0.f, s0 + 1 <= t ? a[1] : 0.f); wv.y = cvt_pk_bf16(s0 + 2 <= t ? a[2] : 0.f, s0 + 3 <= t ? a[3] : 0.f);
                *(LAS u32x2*)(Pm + t * HK_LD + s0) = wv;
            }
#pragma unroll
            for (int it = 0; it < 8; ++it) { u32x2 wv; wv.x = cvt_pk_bf16(S[it][0], S[it][1]); wv.y = cvt_pk_bf16(S[it][2], S[it][3]);
                *(LAS u32x2*)(St + (w * 16 + fr) * HQ_LD + it * 16 + fq * 4) = wv; }
            __syncthreads();
            bf16x8 sf[4];
#pragma unroll
            for (int ks = 0; ks < 4; ++ks) sf[ks] = *(LAS const bf16x8*)(St + (w * 16 + fr) * HQ_LD + ks * 32 + fq * 8);
#pragma unroll
            for (int tt2 = 0; tt2 < 4; ++tt2) {
                f32x4 o = {0.f, 0.f, 0.f, 0.f};
#pragma unroll
                for (int ks = 0; ks < 2; ++ks) { const bf16x8 pf = *(LAS const bf16x8*)(Pm + (tt2 * 16 + fr) * HK_LD + ks * 32 + fq * 8); o = __builtin_amdgcn_mfma_f32_16x16x32_bf16(vf[ks], pf, o, 0, 0, 0); }
#pragma unroll
                for (int ks = 0; ks < 4; ++ks) { const bf16x8 qf = *(LAS const bf16x8*)(QD + (tt2 * 16 + fr) * HQ_LD + ks * 32 + fq * 8); o = __builtin_amdgcn_mfma_f32_16x16x32_bf16(sf[ks], qf, o, 0, 0, 0); }
                const int t = tt2 * 16 + fr;
                if (t < nvalid) { u32x2 wv; wv.x = cvt_pk_bf16(o[0], o[1]); wv.y = cvt_pk_bf16(o[2], o[3]); *(u32x2*)(HQ + (size_t)(r0 + t) * DM + h * 128 + w * 16 + fq * 4) = wv; }
            }
        }
#pragma unroll
        for (int it = 0; it < 8; ++it) {
            const f32x4 d = *(LAS const f32x4*)(decs + it * 16 + fq * 4);
            f32x4 a = S[it] * d;
#pragma unroll
            for (int ks = 0; ks < 2; ++ks) { const bf16x8 kf = *(LAS const bf16x8*)(KEt + (it * 16 + fr) * HK_LD + ks * 32 + fq * 8); a = __builtin_amdgcn_mfma_f32_16x16x32_bf16(kf, vf[ks], a, 0, 0, 0); }
            S[it] = a;
        }
        __syncthreads();
    }
    if (!L3) {
        float* Lp = Lb + ((size_t)((g * 8 + h) * 8 + w) * 8) * 256;
#pragma unroll
        for (int it = 0; it < 8; ++it) *(f32x4*)(Lp + (it * 64 + lane) * 4) = S[it];
        if (tid < 64) { Dg[(g * 8 + h) * 128 + 2 * tid] = __expf(gsum0); Dg[(g * 8 + h) * 128 + 2 * tid + 1] = __expf(gsum1); }
    } else if (g == 31) {
        float* o = p.out + O_HGP + (size_t)h * 16384;
#pragma unroll
        for (int it = 0; it < 8; ++it)
#pragma unroll
            for (int jj = 0; jj < 4; ++jj) o[(it * 16 + fq * 4 + jj) * 128 + w * 16 + fr] = S[it][jj];
    }
}

#undef HG_CHUNK_ROWS
#undef HG_PREFETCH
__device__ __forceinline__ void hgrn_sample_item(const Params& p, LAS unsigned char* lds, int b, int h) {
    const int tid = threadIdx.x;
    LAS float* qS = (LAS float*)lds; LAS float* dS = qS + 1024; LAS float* vS = dS + 1024; LAS float* part = vS + 1024;
    u16* HQ = (u16*)(p.ws + W_S1); const u16* LF = (const u16*)(p.ws + W_S2); const u16* HV = (const u16*)(p.ws + W_S3);
    const int dvq = tid & 31, dkg = tid >> 5;
    const float* s0 = p.in[6] + ((size_t)(b * 8 + h) * 128) * 128;
    f32x4 S[8];
#pragma unroll
    for (int i = 0; i < 8; ++i) S[i] = __builtin_nontemporal_load((const f32x4*)(s0 + (size_t)(dkg + 16 * i) * 128 + 4 * dvq));
    if (tid < 384) {
        const int arr = tid >> 7, j = (tid & 127) >> 4, c8 = (tid & 15) * 8; const size_t a = (size_t)(ROW_S + b * 8 + j) * DM + h * 128 + c8;
        const u32x4 w = *(const u32x4*)((arr == 0 ? LF : (arr == 1 ? (const u16*)HQ : HV)) + a);
        float f[8];
#pragma unroll
        for (int e = 0; e < 4; ++e) { const unsigned lo = w[e] & 0xffffu, hi = w[e] >> 16;
            if (arr == 0) { f[2 * e] = __expf(h2f((u16)lo)); f[2 * e + 1] = __expf(h2f((u16)hi)); }
            else if (arr == 1) { const float q0 = bf2f((u16)lo), q1 = bf2f((u16)hi); f[2 * e] = q0 * sigmoidf_(q0); f[2 * e + 1] = q1 * sigmoidf_(q1); }
            else { f[2 * e] = bf2f((u16)lo); f[2 * e + 1] = bf2f((u16)hi); } }
        LAS float* dst = (arr == 0 ? dS : (arr == 1 ? qS : vS)) + j * 128 + c8;
        *(LAS f32x4*)dst = (f32x4){f[0], f[1], f[2], f[3]}; *(LAS f32x4*)(dst + 4) = (f32x4){f[4], f[5], f[6], f[7]};
    }
    __syncthreads();
#pragma unroll
    for (int j = 0; j < 8; ++j) {
        const f32x4 v = *(LAS const f32x4*)(vS + j * 128 + 4 * dvq);
        f32x4 acc = {0.f, 0.f, 0.f, 0.f};
#pragma unroll
        for (int i = 0; i < 8; ++i) { const int dk = dkg + 16 * i; const float de = dS[j * 128 + dk], q = qS[j * 128 + dk]; const float k = 1.0f - de;
            S[i] = S[i] * de + v * k; acc += S[i] * q; }
        *(LAS f32x4*)(part + (j * 16 + dkg) * 128 + 4 * dvq) = acc;
    }
    float* so = p.out + O_HGS + ((size_t)(b * 8 + h) * 128) * 128;
#pragma unroll
    for (int i = 0; i < 8; ++i) __builtin_nontemporal_store(S[i], (f32x4*)(so + (size_t)(dkg + 16 * i) * 128 + 4 * dvq));
    __syncthreads();
    for (int idx = tid; idx < 1024; idx += 512) { const int j = idx >> 7, d = idx & 127; float s = 0.f;
#pragma unroll
        for (int k2 = 0; k2 < 16; ++k2) s += part[(j * 16 + k2) * 128 + d];
        HQ[(size_t)(ROW_S + b * 8 + j) * DM + h * 128 + d] = f2bf(s); }
    __syncthreads();
}

template <bool FIRST, int NB>
__device__ __forceinline__ void ln_rows(const Params& p, int rowb, int rstride, int lane, const float* gam, const float* bet) {
    u16* X1 = (u16*)(p.ws + W_S1);
    f32x4 x[NB][4];
#pragma unroll
    for (int b = 0; b < NB; ++b) { const u16* xr = X1 + (size_t)(rowb + b * rstride) * DM;
#pragma unroll
        for (int i = 0; i < 4; ++i) { const u32x2 xw = __builtin_nontemporal_load((const u32x2*)(xr + i * 256 + lane * 4)); x[b][i] = (f32x4){bflo(xw.x), bfhi(xw.x), bflo(xw.y), bfhi(xw.y)}; } }
    if (FIRST && NB == 1 && rowb >= ROW_S) {
        const float* pr = (const float*)(p.ws + W_S2) + (size_t)(rowb - ROW_S) * DM;
#pragma unroll
        for (int i = 0; i < 4; ++i) x[0][i] += *(const f32x4*)(pr + i * 256 + lane * 4);
    }
    if (!FIRST && NB == 1 && rowb >= ROW_S) {
        f32x4 pp[8][4];
#pragma unroll
        for (int sl = 0; sl < 8; ++sl) { const float* pr = part_row(p.ws, sl, rowb - ROW_S);
#pragma unroll
            for (int i = 0; i < 4; ++i) pp[sl][i] = *(const f32x4*)(pr + i * 256 + lane * 4); }
#pragma unroll
        for (int i = 0; i < 4; ++i) { f32x4 a = x[0][i] * ALPHA;
#pragma unroll
            for (int sl = 0; sl < 8; ++sl) a += pp[sl][i];
            x[0][i] = a; }
    }
#pragma unroll
    for (int b = 0; b < NB; ++b) {
        float* yr = yrow(p, rowb + b * rstride); const int row = rowb + b * rstride;
        float s = 0.f;
#pragma unroll
        for (int i = 0; i < 4; ++i) s += (x[b][i][0] + x[b][i][1]) + (x[b][i][2] + x[b][i][3]);
#pragma unroll
        for (int o = 1; o < 64; o <<= 1) s += __shfl_xor(s, o);
        const float mu = s * (1.0f / 1024.0f); float q = 0.f;
#pragma unroll
        for (int i = 0; i < 4; ++i) { const f32x4 d = x[b][i] - mu; q += (d[0] * d[0] + d[1] * d[1]) + (d[2] * d[2] + d[3] * d[3]); }
#pragma unroll
        for (int o = 1; o < 64; o <<= 1) q += __shfl_xor(q, o);
        const float rstd = rsqrtf(q * (1.0f / 1024.0f) + 1e-5f);
#pragma unroll
        for (int i = 0; i < 4; ++i) { const int c = i * 256 + lane * 4; const f32x4 gg = *(const f32x4*)(gam + c), bb = *(const f32x4*)(bet + c);
            const f32x4 y = (x[b][i] - mu) * rstd * gg + bb; if (!FIRST) __builtin_nontemporal_store(y, (f32x4*)(yr + c));
            if (FIRST) { u32x2 w; w.x = cvt_pk_bf16(y[0], y[1]); w.y = cvt_pk_bf16(y[2], y[3]); *(u32x2*)(X1 + (size_t)row * DM + c) = w; } }
    }
}
template <bool FIRST>
__device__ __forceinline__ void ln_phase(const Params& p, int bid, int wv, int lane, int G) {
    const float* gam = p.in[FIRST ? 14 : 20]; const float* bet = p.in[FIRST ? 15 : 21];
    const int r0 = bid * 8 + wv, st = G * 8;
    int i = 0;
    for (; r0 + st * (i + 3) < ROW_S; i += 4) ln_rows<FIRST, 4>(p, r0 + st * i, st, lane, gam, bet);
    for (; r0 + st * i < (FIRST ? MROWS : ROW_M); ++i) ln_rows<FIRST, 1>(p, r0 + st * i, st, lane, gam, bet);
}

#define XB_TMO      128
#define XB_XCNT(j)  (256  + 64 * (j))
#define XB_XSUB(j)  (1280 + 64 * (j))
#define XB_XGEN(j)  (2304 + 64 * (j))
#define XB_TOP      3328
#define XB_TOPGEN   3392
#define XCD_BAR_WORDS 3456
#define XB_SPIN_CAP (1u << 18)
static_assert(2 * XCD_BAR_WORDS * 4 <= CTL_BYTES, "barrier words");
__device__ __forceinline__ unsigned xb_ld(unsigned* p)              { return __hip_atomic_load(p, __ATOMIC_RELAXED, __HIP_MEMORY_SCOPE_AGENT); }
__device__ __forceinline__ unsigned xb_add(unsigned* p, unsigned v) { return __hip_atomic_fetch_add(p, v, __ATOMIC_RELAXED, __HIP_MEMORY_SCOPE_AGENT); }
__device__ __forceinline__ unsigned xb_xcc_id() { return (unsigned)__builtin_amdgcn_s_getreg((3 << 11) | 20) & 0xFu; }
#define XB_SPIN(cond, bar) do { unsigned _sp = 0; while (cond) { __builtin_amdgcn_s_sleep(1); \
    if ((++_sp & 255u) == 0u) { if (xb_ld(&(bar)[XB_TMO])) break; if (_sp > XB_SPIN_CAP) { atomicAdd(&(bar)[XB_TMO], 1u); break; } } } } while (0)
struct XcdBarrier { unsigned* bar; unsigned x; volatile LAS unsigned* st; };
__device__ __forceinline__ XcdBarrier xcd_barrier_post(unsigned* bar, volatile LAS unsigned* st) {
    XcdBarrier b; b.bar = bar; b.x = xb_xcc_id(); b.st = st;
    if (threadIdx.x == 0) (void)xb_add(&bar[XB_XCNT(b.x)], 1u);
    return b;
}
__device__ __forceinline__ void xcd_barrier_complete(unsigned* bar, unsigned x, unsigned& nloc, unsigned& nx) {
    const unsigned G = gridDim.x * gridDim.y * gridDim.z;
    unsigned sum, cnt, mine, sp = 0u;
    for (;;) {
        sum = 0u; cnt = 0u; mine = 0u;
#pragma unroll
        for (unsigned j = 0; j < 16; ++j) { const unsigned c = xb_ld(&bar[XB_XCNT(j)]); sum += c; cnt += (c > 0u) ? 1u : 0u; mine = (j == x) ? c : mine; }
        if (sum == G) break;
        __builtin_amdgcn_s_sleep(1);
        if ((++sp & 255u) == 0u) { if (xb_ld(&bar[XB_TMO])) break; if (sp > XB_SPIN_CAP) { atomicAdd(&bar[XB_TMO], 1u); break; } }
    }
    nloc = mine > 0u ? mine : 1u; nx = cnt > 0u ? cnt : 1u;
}
__device__ __forceinline__ void xcd_barrier(const XcdBarrier& b) {
    asm volatile("s_waitcnt vmcnt(0)" ::: "memory");
    __syncthreads();
    if (threadIdx.x == 0) {
        unsigned* bar = b.bar;
        __builtin_amdgcn_s_waitcnt(0);
        unsigned nloc = b.st[0], nx = b.st[1];
        if (nloc == 0u) { xcd_barrier_complete(bar, b.x, nloc, nx); b.st[0] = nloc; b.st[1] = nx; }
        const unsigned old = xb_add(&bar[XB_XSUB(b.x)], 1u);
        const unsigned gen = old / nloc;
        if (old + 1u == (gen + 1u) * nloc) {
            __builtin_amdgcn_fence(__ATOMIC_RELEASE, "agent");
            asm volatile("s_waitcnt vmcnt(0)" ::: "memory");
            const unsigned og = xb_add(&bar[XB_TOP], 1u);
            const unsigned tg = og / nx;
            if (og + 1u == (tg + 1u) * nx) xb_add(&bar[XB_TOPGEN], 1u);
            else XB_SPIN(xb_ld(&bar[XB_TOPGEN]) == tg, bar);
            __builtin_amdgcn_fence(__ATOMIC_ACQUIRE, "agent");
            xb_add(&bar[XB_XGEN(b.x)], 1u);
            asm volatile("s_waitcnt vmcnt(0)" ::: "memory");
        } else {
            XB_SPIN(xb_ld(&bar[XB_XGEN(b.x)]) == gen, bar);
            __builtin_amdgcn_fence(__ATOMIC_ACQUIRE, "agent");
            asm volatile("s_waitcnt vmcnt(0)" ::: "memory");
        }
    }
    __syncthreads();
}

__global__ void __launch_bounds__(512, 2) fwd_megakernel(Params p) {
    extern __shared__ __attribute__((aligned(16))) unsigned char lds_raw[];
    LAS unsigned char* lds = (LAS unsigned char*)lds_raw;
    cg::grid_group grid = cg::this_grid();
    const int tid = threadIdx.x, lane = tid & 63, wv = tid >> 6, G = gridDim.x, bid = blockIdx.x;
    const size_t gtid = (size_t)bid * 512 + tid, gthreads = (size_t)G * 512;
    volatile LAS unsigned* bst = (volatile LAS unsigned*)(lds + LDS_BYTES - 16);
    if (tid == 0) { bst[0] = 0u; bst[1] = 0u; }
    __syncthreads();
    const XcdBarrier gbar = xcd_barrier_post((unsigned*)(p.ws + W_CTL) + p.bli * XCD_BAR_WORDS, bst);
    if (p.ph_lo < 0) grid.sync();

#define IN(k) (p.ph_lo <= (k) && (k) < p.ph_hi)
#define SEAM(k) do { if (IN(k) && IN((k) + 1)) xcd_barrier(gbar); } while (0)
    {
        if (IN(0)) {
            for (int t0 = bid; t0 < 1920 + 256; t0 += 4 * G) {
                TDesc d[4];
#pragma unroll
                for (int q = 0; q < 4; ++q) { const int t = t0 + q * G; d[q].valid = t < 1920 + 256; d[q].perm = false; d[q].K = DM;
                    if (t < 1920) { d[q].W = p.in[9]; d[q].Wt = (u16*)(p.ws + W_WIN); d[q].N = INC; d[q].tile = t; }
                    else { d[q].W = p.in[13]; d[q].Wt = (u16*)(p.ws + W_WOUT); d[q].N = DM; d[q].tile = t - 1920; } }
                transpose4(d, (LAS float*)lds);
            }
            u16* Xb = (u16*)((unsigned char*)p.out + OB_XB);
            for (size_t it = gtid; it < (size_t)MROWS * 128; it += gthreads) { const int row = (int)(it >> 7), cgp = (int)(it & 127);
                const float* s = xrow(p, row) + cgp * 8; const f32x4 a = __builtin_nontemporal_load((const f32x4*)s), b = __builtin_nontemporal_load((const f32x4*)(s + 4));
                u32x4 w; w.x = cvt_pk_bf16(a[0], a[1]); w.y = cvt_pk_bf16(a[2], a[3]); w.z = cvt_pk_bf16(b[0], b[1]); w.w = cvt_pk_bf16(b[2], b[3]);
                *(u32x4*)(Xb + (size_t)row * DM + cgp * 8) = w; }
            if (bid == 0) for (int c = tid; c < 1024; c += 512) { const float a0 = p.in[11][c], a1 = p.in[11][1024 + c], mm = fmaxf(a0, a1), e0 = __expf(a0 - mm), e1 = __expf(a1 - mm);
                ((float*)(p.ws + W_LB))[c] = e0 / (e0 + e1); }
}
        SEAM(0);
        if (IN(1)) {
            pg8::Gemm g{(const u16*)((unsigned char*)p.out + OB_XB), (const u16*)(p.ws + W_WIN), MPAD, INC, DM, DM, DM};
            pg8::StaticOrder S; S.init(ROW_M, INC, DM, G, bid);
            EpiIn E{p};
            pg8::gemm_phase<EpiIn, pg8::StaticOrder>(lds, g, S, E);
            meta_inproj(p, bid, __builtin_amdgcn_readfirstlane(wv), lane, G);
        }
        SEAM(1);
        if (IN(2)) {
            for (int it = bid; it < 256; it += G) hgrn_prompt_item<false>(p, lds, it >> 3, it & 7);
            attn_prompt_items(p, lds, bid, G);
            attn_sample_items(p, lds, bid, G);
            for (int it = bid; it < 1024; it += G) hgrn_sample_item(p, lds, it >> 3, it & 7);
        }
        SEAM(2);
        if (IN(3)) {
            float* Lb = (float*)(p.ws + W_L); const float* Dg = (const float*)(p.ws + W_DG);
            for (int e = bid * 512 + tid; e < 131072; e += G * 512) {
                const int hh = e >> 14, itq = (e >> 8) & 7, ln = (e >> 2) & 63, jj = e & 3, dk = itq * 16 + (ln >> 4) * 4 + jj;
                float Sx = 0.f;
                float lv[32], dv[32];
#pragma unroll
                for (int gg = 0; gg < 32; ++gg) { lv[gg] = Lb[(size_t)gg * 131072 + e]; dv[gg] = Dg[(gg * 8 + hh) * 128 + dk]; }
#pragma unroll
                for (int gg = 0; gg < 32; ++gg) { Lb[(size_t)gg * 131072 + e] = Sx; Sx = dv[gg] * Sx + lv[gg]; }
            }
            xcd_barrier(gbar);
        }
        if (IN(3)) {
            for (int it = bid; it < 256; it += G) hgrn_prompt_item<true>(p, lds, it >> 3, it & 7);
        }
        SEAM(3);
        if (IN(4)) {
            const u16* OH = (const u16*)(p.ws + W_S1); u16* HG = (u16*)(p.ws + W_S4); const u16* GA = (const u16*)(p.ws + W_S5); const u16* GB = (const u16*)(p.ws + W_S6);
            const u16* OA = (const u16*)((const unsigned char*)p.out + OB_Q); const float* ng = p.in[12];
            for (int row0 = bid * 8 + wv; row0 < MROWS; row0 += G * 16) {
                u32x4 oh[2][2], hgv[2][2], gav[2][2], gbv[2][2], oav[2][2];
#pragma unroll
                for (int rr = 0; rr < 2; ++rr) { const int row = min(row0 + rr * G * 8, MROWS - 1);
#pragma unroll
                    for (int hf = 0; hf < 2; ++hf) { const size_t a = (size_t)row * DM + hf * 512 + lane * 8;
                        oh[rr][hf] = __builtin_nontemporal_load((const u32x4*)(OH + a)); hgv[rr][hf] = __builtin_nontemporal_load((const u32x4*)(HG + a)); gav[rr][hf] = __builtin_nontemporal_load((const u32x4*)(GA + a)); gbv[rr][hf] = __builtin_nontemporal_load((const u32x4*)(GB + a)); oav[rr][hf] = __builtin_nontemporal_load((const u32x4*)(OA + a)); } }
#pragma unroll
                for (int rr = 0; rr < 2; ++rr) {
                    const int row = row0 + rr * G * 8;
                    float ss = 0.f;
#pragma unroll
                    for (int hf = 0; hf < 2; ++hf)
#pragma unroll
                        for (int j = 0; j < 4; ++j) { const float a = bflo(oh[rr][hf][j]), b = bfhi(oh[rr][hf][j]); ss += a * a + b * b; }
#pragma unroll
                    for (int o = 1; o < 64; o <<= 1) ss += __shfl_xor(ss, o);
                    const float rstd = rsqrtf(ss * (1.0f / 1024.0f) + 1e-6f);
                    if (row < MROWS) {
#pragma unroll
                        for (int hf = 0; hf < 2; ++hf) { const size_t a = (size_t)row * DM + hf * 512 + lane * 8;
                            const u32x4 hg = hgv[rr][hf], ga = gav[rr][hf], gb = gbv[rr][hf], oa = oav[rr][hf];
                            const f32x4 n0 = *(const f32x4*)(ng + hf * 512 + lane * 8), n1 = *(const f32x4*)(ng + hf * 512 + lane * 8 + 4);
                            float v[8];
#pragma unroll
                            for (int j = 0; j < 4; ++j) {
                                const float g0 = (j < 2) ? n0[2 * j] : n1[2 * j - 4], g1 = (j < 2) ? n0[2 * j + 1] : n1[2 * j - 3];
                                const float h0 = bflo(hg[j]), h1 = bfhi(hg[j]);
                                v[2 * j] = sigmoidf_(bflo(ga[j])) * bflo(oa[j]) + sigmoidf_(bflo(gb[j])) * (bflo(oh[rr][hf][j]) * rstd * g0) * (h0 * sigmoidf_(h0));
                                v[2 * j + 1] = sigmoidf_(bfhi(ga[j])) * bfhi(oa[j]) + sigmoidf_(bfhi(gb[j])) * (bfhi(oh[rr][hf][j]) * rstd * g1) * (h1 * sigmoidf_(h1));
                            }
                            *(u32x4*)(HG + a) = pack8(v); }
                    }
                }
            }
        }
        SEAM(4);
        if (IN(5)) {
            pg8::Gemm g{(const u16*)(p.ws + W_S4), (const u16*)(p.ws + W_WOUT), MPAD, DM, DM, DM, DM};
            pg8::TailOrder S; S.init(DM, G, bid);
            EpiRes1 E{p};
            pg8::gemm_phase<EpiRes1, pg8::TailOrder>(lds, g, S, E);
            if (bid >= 40) {
                for (int t0 = bid - 40; t0 < 1408 + 704; t0 += 4 * (G - 40)) {
                    TDesc d[4];
#pragma unroll
                    for (int q = 0; q < 4; ++q) { const int t = t0 + q * (G - 40); d[q].valid = t < 1408 + 704;
                        if (t < 1408) { d[q].W = p.in[16]; d[q].Wt = (u16*)(p.ws + W_WUP); d[q].K = DM; d[q].N = UVW; d[q].tile = t; d[q].perm = true; }
                        else { d[q].W = p.in[19]; d[q].Wt = (u16*)(p.ws + W_WDN); d[q].K = DFF; d[q].N = DM; d[q].tile = t - 1408; d[q].perm = false; } }
                    transpose4(d, (LAS float*)lds);
                }
                for (size_t it = (size_t)(bid - 40) * 512 + tid; it < (size_t)2 * NBATCH * 120 * 64; it += (size_t)(G - 40) * 512) { const int sel = (int)(it / ((size_t)NBATCH * 120 * 64)); const size_t r = it % ((size_t)NBATCH * 120 * 64);
                    const int b = (int)(r / (120 * 64)), q = (int)(r % (120 * 64));
                    const f32x4 v = __builtin_nontemporal_load((const f32x4*)(p.in[4 + sel] + ((size_t)b * 128 + 8) * 256 + (size_t)q * 4));
                    __builtin_nontemporal_store(v, (f32x4*)(p.out + (sel ? O_WINVS : O_WINKS) + (size_t)b * 128 * 256 + (size_t)q * 4)); }
                    }
        }
        SEAM(5);
        if (IN(6)) {
            ln_phase<true>(p, bid, wv, lane, G);
        }
        SEAM(6);
        if (IN(7)) {
            pg8::Gemm g{(const u16*)(p.ws + W_S1), (const u16*)(p.ws + W_WUP), MPAD, UVW, DM, DM, DM};
            pg8::StaticOrder S; S.init(MPAD, UVW, DM, G, bid);
            EpiUp E{p, (LAS float*)(lds + 131072)};
            pg8::gemm_phase<EpiUp, pg8::StaticOrder>(lds, g, S, E);
        }
        SEAM(7);
        if (IN(9)) {
            pg8::Gemm g{(const u16*)(p.ws + W_UV) + DFF, (const u16*)(p.ws + W_WDN), MPAD, DM, DFF, UVW, DFF};
            pg8::SplitOrder S; S.init(DFF, G, bid);
            {
                pg8::Unit u0;
                if (S.next(0, u0)) {
                    u16* UV = (u16*)(p.ws + W_UV); const float* cw = p.in[17]; const float* cb = p.in[18];
                    const u16* HA = (const u16*)(p.ws + W_HALO) + (size_t)(u0.pm == 0 ? 69 : u0.pm - 1) * 2 * DFF;
                    const u16* FU = (const u16*)(p.ws + W_FIXU) + (size_t)u0.pm * 2 * DFF; const u16* FV = (const u16*)(p.ws + W_FIXV) + (size_t)u0.pm * 2 * DFF;
                    for (int idx = tid; idx < 2 * 352; idx += 512) {
                        const int r = idx / 352, c = (idx % 352) * 8;
                        const u32x4 h0 = *(const u32x4*)(HA + c), h1 = *(const u32x4*)(HA + DFF + c), f0 = *(const u32x4*)(FU + c), f1 = *(const u32x4*)(FU + DFF + c), fv = *(const u32x4*)(FV + (size_t)r * DFF + c);
                        const u32x4 a2 = r == 0 ? h0 : h1, a1 = r == 0 ? h1 : f0, a0 = r == 0 ? f0 : f1;
                        const f32x4 w0a = *(const f32x4*)(cw + c), w0b = *(const f32x4*)(cw + c + 4), w1a = *(const f32x4*)(cw + DFF + c), w1b = *(const f32x4*)(cw + DFF + c + 4),
                                    w2a = *(const f32x4*)(cw + 2 * DFF + c), w2b = *(const f32x4*)(cw + 2 * DFF + c + 4), ba = *(const f32x4*)(cb + c), bb = *(const f32x4*)(cb + c + 4);
                        float hv[8];
#pragma unroll
                        for (int e = 0; e < 8; ++e) {
                            const float x2 = (e & 1) ? bfhi(a2[e >> 1]) : bflo(a2[e >> 1]), x1 = (e & 1) ? bfhi(a1[e >> 1]) : bflo(a1[e >> 1]), x0 = (e & 1) ? bfhi(a0[e >> 1]) : bflo(a0[e >> 1]);
                            const float vl = (e & 1) ? bfhi(fv[e >> 1]) : bflo(fv[e >> 1]);
                            const float w0 = e < 4 ? w0a[e & 3] : w0b[e & 3], w1 = e < 4 ? w1a[e & 3] : w1b[e & 3], w2 = e < 4 ? w2a[e & 3] : w2b[e & 3], b0 = e < 4 ? ba[e & 3] : bb[e & 3];
                            hv[e] = gelu_tanh_f(b0 + w0 * x2 + w1 * x1 + w2 * x0) * vl;
                        }
                        *(u32x4*)(UV + (size_t)(u0.pm * 256 + r) * UVW + DFF + c) = pack8(hv);
                    }
                    __threadfence();
                    __syncthreads();
                }
            }
            EpiRes2 E{p};
            pg8::gemm_phase<EpiRes2, pg8::SplitOrder>(lds, g, S, E);
        }
        SEAM(9);
        if (IN(10)) ln_phase<false>(p, bid, wv, lane, G);
    }
}

constexpr int N_PHASES = 11;
#ifndef PH_HI
#define PH_HI N_PHASES
#endif

extern "C" void kernel_launch(void* const* d_in, const int* in_sizes, int n_in, void* d_out, int out_size, void* d_ws, size_t ws_size, hipStream_t stream) {
    static int grid_blocks = 0;
    if (!grid_blocks) {
        if (n_in != 22 || ws_size < WS_NEED || out_size != 43922944) { fprintf(stderr, "kernel_launch: unexpected problem (n_in %d, ws %zu, out %d)\n", n_in, ws_size, out_size); grid_blocks = -1; return; }
        int dev = 0, cus = 0, per_cu = 0;
        hipGetDevice(&dev);
        hipDeviceGetAttribute(&cus, hipDeviceAttributeMultiprocessorCount, dev);
        hipFuncSetAttribute((const void*)fwd_megakernel, hipFuncAttributeMaxDynamicSharedMemorySize, LDS_BYTES);
        hipOccupancyMaxActiveBlocksPerMultiprocessor(&per_cu, (const void*)fwd_megakernel, 512, LDS_BYTES);
        if (per_cu < 1) { fprintf(stderr, "kernel_launch: occupancy query says %d blocks per CU\n", per_cu); per_cu = 1; }
        grid_blocks = cus;
    }
    if (grid_blocks < 0) return;
    Params p{};
    for (int i = 0; i < 22; ++i) p.in[i] = (const float*)d_in[i];
    p.out = (float*)d_out; p.ws = (unsigned char*)d_ws;
    (void)hipMemsetAsync((unsigned char*)d_ws + W_CTL, 0, CTL_BYTES, stream);
#ifdef PREFIX_K
    { Params q = p; q.ph_lo = 0; q.ph_hi = PREFIX_K; q.bli = 1; void* a2[] = {&q};
      hipLaunchCooperativeKernel((const void*)fwd_megakernel, dim3(grid_blocks), dim3(512), a2, LDS_BYTES, stream); }
#endif
    p.ph_lo = 0; p.ph_hi = PH_HI;
    void* args[] = {&p};
    hipError_t e = hipLaunchCooperativeKernel((const void*)fwd_megakernel, dim3(grid_blocks), dim3(512), args, LDS_BYTES, stream);
    if (e != hipSuccess) fprintf(stderr, "cooperative launch failed: %s (grid %d)\n", hipGetErrorString(e), grid_blocks);
}
```

```cpp
#include <hip/hip_runtime.h>
#include <hip/hip_cooperative_groups.h>
#include <cstdio>
#include <cstdint>
namespace cg = cooperative_groups;

#define LAS __attribute__((address_space(3)))
typedef unsigned short u16;
typedef short bf16x8 __attribute__((ext_vector_type(8)));
typedef float f32x4 __attribute__((ext_vector_type(4)));
typedef unsigned u32x4 __attribute__((ext_vector_type(4)));
typedef unsigned u32x2 __attribute__((ext_vector_type(2)));

constexpr int DM = 1024, NPR = 16384, NSM = 1024, NMETA = 16;
constexpr int ROW_S = 16384, ROW_M = 17408, MROWS = 17424, MPAD = 17664;
constexpr int INC = 7680, DFF = 2816, UVW = 5632;
constexpr int NBATCH = 128, NTOK = 8;
constexpr float ALPHA = 1.189207115002721f;
constexpr size_t O_Y = 0, O_METAK = 17825792, O_METAV = 17829888, O_WINKP = 17833984, O_WINVP = 17866752, O_HGP = 17899520,
                 O_CONVP = 18030592, O_WINKS = 18036224, O_WINVS = 22230528, O_HGS = 26424832, O_CONVS = 43202048;
constexpr size_t OB_Q = 0;
constexpr size_t OB_KV = (size_t)MROWS * 2048;
constexpr size_t OB_XB = O_HGS * 4;
constexpr size_t SLOT = (size_t)MROWS * 2048;
constexpr size_t W_WIN = 0, W_WUP = 0, W_WDN = (size_t)UVW * DM * 2;
constexpr size_t W_S1 = 17825792, W_S2 = W_S1 + SLOT, W_S3 = W_S2 + SLOT, W_S4 = W_S3 + SLOT, W_S5 = W_S4 + SLOT, W_S6 = W_S5 + SLOT;
constexpr size_t W_L = W_S6 + SLOT;
constexpr size_t W_UV = W_S2;
constexpr size_t W_SMALL = (size_t)250 * 1024 * 1024;
constexpr size_t W_WOUT = W_SMALL + (size_t)2 * 1024 * 1024;
constexpr size_t W_CTL = W_SMALL + (size_t)1280 * 1024;
constexpr size_t CTL_BYTES = 32768;
constexpr size_t W_HALO = W_SMALL + (size_t)4 * 1024 * 1024;
constexpr size_t W_FIXU = W_HALO + (size_t)70 * 2 * DFF * 2;
constexpr size_t W_FIXV = W_SMALL + 4096 + 131072 + 65536;
static_assert(W_FIXU + (size_t)64 * 2 * DFF * 2 <= (size_t)256 * 1024 * 1024 && W_FIXV + (size_t)64 * 2 * DFF * 2 <= W_CTL, "halo buffers");
__device__ __forceinline__ float* part_row(unsigned char* ws, int sl, int r) { return (float*)(ws + W_UV + ((size_t)sl * 1024 + r) * ((size_t)UVW * 2)); }
constexpr size_t W_LB = W_SMALL, W_DG = W_SMALL + 4096, W_YT = W_SMALL + 4096 + 131072;
constexpr size_t WS_NEED = (size_t)256 * 1024 * 1024;
static_assert(W_L + 16777216 <= W_SMALL && W_UV + (size_t)MPAD * UVW * 2 <= W_SMALL && W_YT + 1048576 <= WS_NEED, "ws layout");
static_assert(W_WOUT + 2097152 <= WS_NEED && W_WDN + (size_t)DM * DFF * 2 <= W_S1 && (size_t)INC * DM * 2 <= W_S1, "ws layout");
constexpr int LDS_BYTES = 155648;

struct Params { const float* in[22]; float* out; unsigned char* ws; int ph_lo, ph_hi, bli, pad; };

typedef __bf16 bf16x2_t __attribute__((ext_vector_type(2)));
typedef float f32x2_t __attribute__((ext_vector_type(2)));
__device__ __forceinline__ unsigned cvt_pk_bf16(float lo, float hi) { bf16x2_t r = __builtin_convertvector((f32x2_t){lo, hi}, bf16x2_t); return __builtin_bit_cast(unsigned, r); }
__device__ __forceinline__ float bf2f(u16 v) { return __uint_as_float((unsigned)v << 16); }
__device__ __forceinline__ float bflo(unsigned w) { return __uint_as_float(w << 16); }
__device__ __forceinline__ float bfhi(unsigned w) { return __uint_as_float(w & 0xffff0000u); }
__device__ __forceinline__ u16 f2bf(float f) { return (u16)(cvt_pk_bf16(f, 0.f) & 0xffffu); }
__device__ __forceinline__ float h2f(u16 v) { return (float)__builtin_bit_cast(_Float16, v); }
__device__ __forceinline__ u16 f2h(float f) { return __builtin_bit_cast(u16, (_Float16)f); }
__device__ __forceinline__ float sigmoidf_(float x) { return __builtin_amdgcn_rcpf(1.0f + __expf(-x)); }
__device__ __forceinline__ u32x4 pack8(const float* v) { u32x4 w; w.x = cvt_pk_bf16(v[0], v[1]); w.y = cvt_pk_bf16(v[2], v[3]); w.z = cvt_pk_bf16(v[4], v[5]); w.w = cvt_pk_bf16(v[6], v[7]); return w; }
__device__ __forceinline__ const float* xrow(const Params& p, int row) {
    return row < ROW_S ? p.in[0] + (size_t)row * DM : (row < ROW_M ? p.in[1] + (size_t)(row - ROW_S) * DM : p.in[8] + (size_t)(row - ROW_M) * DM);
}
__device__ __forceinline__ float* yrow(const Params& p, int row) {
    return row < ROW_M ? p.out + (size_t)row * DM : (float*)(p.ws + W_YT) + (size_t)(row - ROW_M) * DM;
}

namespace pg8 {
constexpr int BM = 256, BK = 64, HALF = 128, HTB = HALF * BK * 2, NXCD = 8, WGM = 8;
__device__ __forceinline__ int lds_byte(int r, int c) { const int st = (r >> 4) * 2 + (c >> 5), rr = r & 15, cc = c & 31, ob = rr * 64 + cc * 2; return st * 1024 + (ob ^ (((ob >> 9) & 1) << 5)); }
__device__ __forceinline__ void stage_rc(int b, int& R, int& C) { const int st = b / 1024, sb = b % 1024, swz = sb ^ (((sb >> 9) & 1) << 5); R = (st >> 1) * 16 + swz / 64; C = (st & 1) * 32 + (swz % 64) / 2; }
__device__ __forceinline__ int perm32(int rho) { const int n = rho >> 4, i = rho & 15; return 8 * (i >> 2) + 4 * n + (i & 3); }
struct Unit { int pm, pn, k0, nk, sl; };
struct Gemm { const u16* A; const u16* Bt; int M, N, K, lda, ldb; };
struct StaticOrder {
    int nM, nN, nwg, G, c, nkt;
    __device__ __forceinline__ void init(int M, int N, int K, int G_, int c_) { nM = M / BM; nN = N / BM; nwg = nM * nN; G = G_; c = c_; nkt = K / BK; }
    __device__ __forceinline__ bool next(int i, Unit& u) const {
        const long L = (long)i * G + c; if (L >= nwg) return false;
        int wgid = (int)L; { const int q = nwg / NXCD, r = nwg % NXCD, xcd = wgid % NXCD, off = wgid / NXCD; wgid = (xcd < r ? xcd * (q + 1) : r * (q + 1) + (xcd - r) * q) + off; }
        const int nig = WGM * nN, gid = wgid / nig, fm = gid * WGM, gsz = (nM - fm) < WGM ? (nM - fm) : WGM;
        u.pm = fm + ((wgid % nig) % gsz); u.pn = (wgid % nig) / gsz; u.k0 = 0; u.nk = nkt; u.sl = -1; return true;
    }
};
struct SplitOrder {
    StaticOrder base; int c;
    __device__ __forceinline__ void init(int K, int G_, int c_) { base.init(NPR, DM, K, G_, c_); c = c_; }
    __device__ __forceinline__ bool next(int i, Unit& u) const {
        if (i == 0) return base.next(0, u);
        if (i > 1 || c >= 128) return false;
        const int tile = c >> 3, sl = c & 7;
        u.pm = 64 + (tile >> 2); u.pn = tile & 3; u.sl = sl; u.k0 = sl < 6 ? sl * 6 : 36 + (sl - 6) * 4; u.nk = sl < 6 ? 6 : 4; return true;
    }
};
struct TailOrder {
    StaticOrder base; int c;
    __device__ __forceinline__ void init(int K, int G_, int c_) { base.init(NPR, DM, K, G_, c_); c = c_; }
    __device__ __forceinline__ bool next(int i, Unit& u) const {
        if (i == 0) return base.next(0, u);
        if (i > 1 || c >= 40) return false;
        const int tile = c >> 1, h = c & 1;
        u.pm = 64 + (tile >> 2); u.pn = tile & 3; u.k0 = h * (base.nkt >> 1); u.nk = base.nkt >> 1; u.sl = h; return true;
    }
};
template <class Epi, class Sched>
__device__ __forceinline__ void gemm_phase(LAS unsigned char* lds, const Gemm g, const Sched& S, const Epi& E) {
    const int tid = threadIdx.x, wid = __builtin_amdgcn_readfirstlane(tid >> 6), lane = tid & 63, wr = wid >> 2, wc = wid & 3, fr = lane & 15, fq = lane >> 4;
    unsigned voffA[2], voffB[2];
#pragma unroll
    for (int i = 0; i < 2; ++i) { int R, C; stage_rc(tid * 16 + i * 8192, R, C); const int Rb = (R & ~31) + perm32(R & 31);
        voffA[i] = (unsigned)(R * g.lda + C) * 2u; voffB[i] = (unsigned)(Rb * g.ldb + C) * 2u; }
    const size_t kstep = (size_t)(BK * 2);
    const size_t hstepA = (size_t)HALF * g.lda * 2, hstepB = (size_t)HALF * g.ldb * 2;
    const size_t tstepA = 2 * hstepA, tstepB = 2 * hstepB;
    const unsigned ldsw = (unsigned)wid * 1024u;
    const int aoff = lds_byte(wr * 64 + fr, fq * 8), boff = lds_byte(wc * 32 + fr, fq * 8);
#define PG8_SA(b, h) (((b) * 2 + (h)) * HTB)
#define PG8_SB(b, h) ((4 + (b) * 2 + (h)) * HTB)
#define PG8_STAGE(bufoff, gbase, voff) do { _Pragma("unroll") for (int _i = 0; _i < 2; ++_i) \
        __builtin_amdgcn_global_load_lds((const unsigned*)((const char*)(gbase) + (voff)[_i]), (LAS unsigned*)(lds + (bufoff) + ldsw + _i * 8192), 16, 0, 0); } while (0)
#define PG8_LDA(dst, b, h) do { _Pragma("unroll") for (int m = 0; m < 4; ++m) _Pragma("unroll") for (int k = 0; k < 2; ++k) dst[m][k] = *(const LAS bf16x8*)(lds + PG8_SA(b, h) + aoff + m * 2048 + k * 1024); } while (0)
#define PG8_LDB(dst, b, h) do { _Pragma("unroll") for (int n = 0; n < 2; ++n) _Pragma("unroll") for (int k = 0; k < 2; ++k) dst[n][k] = *(const LAS bf16x8*)(lds + PG8_SB(b, h) + boff + n * 2048 + k * 1024); } while (0)
#define PG8_MMA(ai, bj, At, Bt) do { __builtin_amdgcn_s_setprio(1); _Pragma("unroll") for (int m = 0; m < 4; ++m) _Pragma("unroll") for (int n = 0; n < 2; ++n) _Pragma("unroll") for (int k = 0; k < 2; ++k) \
        acc[ai][bj][m][n] = __builtin_amdgcn_mfma_f32_16x16x32_bf16(Bt[n][k], At[m][k], acc[ai][bj][m][n], 0, 0, 0); __builtin_amdgcn_s_setprio(0); } while (0)
#define PG8_WAIT_V(n) asm volatile("s_waitcnt vmcnt(" #n ")" ::: "memory")
#define PG8_WAIT_L(n) asm volatile("s_waitcnt lgkmcnt(" #n ")" ::: "memory")
#define PG8_BAR __builtin_amdgcn_s_barrier()
#define PG8_SCHED __builtin_amdgcn_sched_barrier(0)
    Unit cur, nxt; int ui = 0;
    if (!S.next(0, cur)) return;
    f32x4 acc[2][2][4][2];
#pragma unroll
    for (int a = 0; a < 2; ++a)
#pragma unroll
        for (int b = 0; b < 2; ++b)
#pragma unroll
            for (int m = 0; m < 4; ++m)
#pragma unroll
                for (int n = 0; n < 2; ++n) acc[a][b][m][n] = (f32x4){0.f, 0.f, 0.f, 0.f};
    bf16x8 At[4][2], B0[2][2], B1[2][2];
    const char* cA = (const char*)g.A + (size_t)cur.pm * tstepA + (size_t)cur.k0 * kstep; const char* cB = (const char*)g.Bt + (size_t)cur.pn * tstepB + (size_t)cur.k0 * kstep;
    PG8_STAGE(PG8_SB(0, 0), cB, voffB); PG8_STAGE(PG8_SB(0, 1), cB + hstepB, voffB); PG8_STAGE(PG8_SA(0, 0), cA, voffA); PG8_STAGE(PG8_SA(0, 1), cA + hstepA, voffA);
    if (wr == 1) PG8_BAR;
    PG8_WAIT_V(2); PG8_BAR;
    PG8_STAGE(PG8_SB(1, 0), cB + kstep, voffB); PG8_STAGE(PG8_SA(1, 0), cA + kstep, voffA); PG8_STAGE(PG8_SB(1, 1), cB + hstepB + kstep, voffB);
    PG8_WAIT_V(6); PG8_BAR;
    for (;;) {
        const bool has_next = S.next(ui + 1, nxt);
        const char* nA = has_next ? (const char*)g.A + (size_t)nxt.pm * tstepA + (size_t)nxt.k0 * kstep : cA; const char* nB = has_next ? (const char*)g.Bt + (size_t)nxt.pn * tstepB + (size_t)nxt.k0 * kstep : cB;
        const int nt = cur.nk;
        for (int t = 0; t < nt; t += 2) {
            const bool last = (t == nt - 2);
            const char* a1 = cA + (size_t)(t + 1) * kstep;
            const char* a2 = last ? nA : cA + (size_t)(t + 2) * kstep; const char* b2 = last ? nB : cB + (size_t)(t + 2) * kstep;
            const char* a3 = a2 + kstep; const char* b3 = b2 + kstep;
            PG8_LDB(B0, 0, 0); PG8_LDB(B1, 0, 1); PG8_SCHED; PG8_LDA(At, 0, 0); PG8_STAGE(PG8_SA(1, 1), a1 + hstepA, voffA);
            PG8_WAIT_V(8); PG8_WAIT_L(0); PG8_BAR; PG8_MMA(0, 0, At, B0); PG8_MMA(0, 1, At, B1); PG8_BAR; PG8_SCHED;
            PG8_LDA(At, 0, 1); PG8_STAGE(PG8_SB(0, 0), b2, voffB); PG8_STAGE(PG8_SB(0, 1), b2 + hstepB, voffB); PG8_STAGE(PG8_SA(0, 0), a2, voffA);
            PG8_WAIT_V(8); PG8_WAIT_L(0); PG8_BAR; PG8_MMA(1, 0, At, B0); PG8_MMA(1, 1, At, B1); PG8_BAR; PG8_SCHED;
            PG8_LDB(B0, 1, 0); PG8_LDB(B1, 1, 1); PG8_SCHED; PG8_LDA(At, 1, 0); PG8_STAGE(PG8_SA(0, 1), a2 + hstepA, voffA);
            PG8_WAIT_V(8); PG8_WAIT_L(0); PG8_BAR; PG8_MMA(0, 0, At, B0); PG8_MMA(0, 1, At, B1); PG8_BAR; PG8_SCHED;
            PG8_LDA(At, 1, 1); PG8_STAGE(PG8_SB(1, 0), b3, voffB); PG8_STAGE(PG8_SB(1, 1), b3 + hstepB, voffB); PG8_STAGE(PG8_SA(1, 0), a3, voffA);
            PG8_WAIT_V(8); PG8_WAIT_L(0); PG8_BAR; PG8_MMA(1, 0, At, B0); PG8_MMA(1, 1, At, B1); PG8_BAR; PG8_SCHED;
        }
        if (wr == 0) PG8_BAR;
        E(acc, cur, wr, wc, fr, fq);
        if (!has_next) break;
#pragma unroll
        for (int a = 0; a < 2; ++a)
#pragma unroll
            for (int b = 0; b < 2; ++b)
#pragma unroll
                for (int m = 0; m < 4; ++m)
#pragma unroll
                    for (int n = 0; n < 2; ++n) acc[a][b][m][n] = (f32x4){0.f, 0.f, 0.f, 0.f};
        cur = nxt; cA = nA; cB = nB; ++ui;
        if (wr == 1) PG8_BAR;
    }
    PG8_WAIT_V(0);
    PG8_BAR;
#undef PG8_SA
#undef PG8_SB
#undef PG8_STAGE
#undef PG8_LDA
#undef PG8_LDB
#undef PG8_MMA
#undef PG8_WAIT_V
#undef PG8_WAIT_L
#undef PG8_BAR
#undef PG8_SCHED
}
}
using pg8::Unit;

struct EpiIn {
    static constexpr bool PERM = true;
    Params p;
    __device__ __forceinline__ void operator()(const f32x4 (&acc)[2][2][4][2], const Unit& u, int wr, int wc, int fr, int fq) const {
        const int pn = u.pn;
        int mode, ld, c0; u16* base;
        if (pn < 4) { mode = 0; base = (u16*)((unsigned char*)p.out + OB_Q); ld = 1024; c0 = pn * 256; }
        else if (pn < 6) { mode = 1; base = (u16*)((unsigned char*)p.out + OB_KV); ld = 512; c0 = (pn - 4) * 256; }
        else { const int g = (pn - 6) >> 2; c0 = ((pn - 6) & 3) * 256; ld = 1024; base = (u16*)(p.ws + W_S1 + (size_t)g * SLOT);
               mode = (g == 1) ? 3 : 4; }
        const float* lb = (const float*)(p.ws + W_LB);
#pragma unroll
        for (int ai = 0; ai < 2; ++ai)
#pragma unroll
            for (int m = 0; m < 4; ++m) {
                const int row = u.pm * 256 + ai * 128 + wr * 64 + m * 16 + fr;
                if (row >= MROWS) continue;
                float* fo = nullptr;
                if (mode == 1) {
                    const size_t sel = (pn == 4) ? 0 : 1;
                    if (row >= ROW_M) fo = p.out + (sel ? O_METAV : O_METAK) + (size_t)(row - ROW_M) * 256;
                    else if (row >= ROW_S) { const int s = row - ROW_S; fo = p.out + (sel ? O_WINVS : O_WINKS) + ((size_t)(s >> 3) * 128 + 120 + (s & 7)) * 256; }
                    else if (row >= NPR - 128) fo = p.out + (sel ? O_WINVP : O_WINKP) + (size_t)(row - (NPR - 128)) * 256;
                }
#pragma unroll
                for (int bj = 0; bj < 2; ++bj) {
                    const int cl = bj * 128 + wc * 32 + 8 * fq;
                    float v[8];
#pragma unroll
                    for (int j = 0; j < 4; ++j) { v[j] = acc[ai][bj][m][0][j]; v[4 + j] = acc[ai][bj][m][1][j]; }
                    if (mode == 0) {
#pragma unroll
                        for (int j = 0; j < 8; ++j) v[j] *= 0.125f;
                    } else if (mode == 1) {
                        if (fo) { *(f32x4*)(fo + cl) = (f32x4){v[0], v[1], v[2], v[3]}; *(f32x4*)(fo + cl + 4) = (f32x4){v[4], v[5], v[6], v[7]}; }
                    } else if (mode == 2) {
#pragma unroll
                        for (int j = 0; j < 8; ++j) v[j] = v[j] * sigmoidf_(v[j]);
                    } else if (mode == 3) {
                        const f32x4 l0 = *(const f32x4*)(lb + c0 + cl), l1 = *(const f32x4*)(lb + c0 + cl + 4);
                        u32x4 w; unsigned hh[8];
#pragma unroll
                        for (int j = 0; j < 8; ++j) { const float l = j < 4 ? l0[j] : l1[j - 4]; const float f = l + (1.0f - l) * sigmoidf_(v[j]); hh[j] = f2h(__logf(f)); }
                        w.x = hh[0] | (hh[1] << 16); w.y = hh[2] | (hh[3] << 16); w.z = hh[4] | (hh[5] << 16); w.w = hh[6] | (hh[7] << 16);
                        *(u32x4*)(base + (size_t)row * ld + c0 + cl) = w;
                        continue;
                    } else if (mode == 5) {
#pragma unroll
                        for (int j = 0; j < 8; ++j) v[j] = sigmoidf_(v[j]);
                    }
                    *(u32x4*)(base + (size_t)row * ld + c0 + cl) = pack8(v);
                }
            }
    }
};
struct EpiRes1 {
    static constexpr bool PERM = true;
    Params p;
    __device__ __forceinline__ void operator()(const f32x4 (&acc)[2][2][4][2], const Unit& u, int wr, int wc, int fr, int fq) const {
#pragma unroll
        for (int ai = 0; ai < 2; ++ai)
#pragma unroll
            for (int m = 0; m < 4; ++m) {
                const int row = u.pm * 256 + ai * 128 + wr * 64 + m * 16 + fr;
                if (row >= MROWS) continue;
                if (u.sl == 1) {
                    float* pr = (float*)(p.ws + W_S2) + (size_t)(row - ROW_S) * DM;
#pragma unroll
                    for (int bj = 0; bj < 2; ++bj) { const int c = u.pn * 256 + bj * 128 + wc * 32 + 8 * fq;
                        *(f32x4*)(pr + c) = acc[ai][bj][m][0]; *(f32x4*)(pr + c + 4) = acc[ai][bj][m][1]; }
                    continue;
                }
                const float* xr = xrow(p, row); u16* yr = (u16*)(p.ws + W_S1) + (size_t)row * DM;
#pragma unroll
                for (int bj = 0; bj < 2; ++bj) {
                    const int c = u.pn * 256 + bj * 128 + wc * 32 + 8 * fq;
                    const f32x4 x0 = __builtin_nontemporal_load((const f32x4*)(xr + c)), x1 = __builtin_nontemporal_load((const f32x4*)(xr + c + 4));
                    const f32x4 y0 = x0 * ALPHA + acc[ai][bj][m][0], y1 = x1 * ALPHA + acc[ai][bj][m][1];
                    u32x4 w; w.x = cvt_pk_bf16(y0[0], y0[1]); w.y = cvt_pk_bf16(y0[2], y0[3]); w.z = cvt_pk_bf16(y1[0], y1[1]); w.w = cvt_pk_bf16(y1[2], y1[3]);
                    *(u32x4*)(yr + c) = w;
                }
            }
    }
};
struct EpiRes2 {
    static constexpr bool PERM = true;
    Params p;
    __device__ __forceinline__ void operator()(const f32x4 (&acc)[2][2][4][2], const Unit& u, int wr, int wc, int fr, int fq) const {
#pragma unroll
        for (int ai = 0; ai < 2; ++ai)
#pragma unroll
            for (int m = 0; m < 4; ++m) {
                const int row = u.pm * 256 + ai * 128 + wr * 64 + m * 16 + fr;
                if (u.sl >= 0) {
                    float* pr = part_row(p.ws, u.sl, row - ROW_S);
#pragma unroll
                    for (int bj = 0; bj < 2; ++bj) { const int c = u.pn * 256 + bj * 128 + wc * 32 + 8 * fq;
                        *(f32x4*)(pr + c) = acc[ai][bj][m][0]; *(f32x4*)(pr + c + 4) = acc[ai][bj][m][1]; }
                    continue;
                }
                u16* xr = (u16*)(p.ws + W_S1) + (size_t)row * DM;
#pragma unroll
                for (int bj = 0; bj < 2; ++bj) {
                    const int c = u.pn * 256 + bj * 128 + wc * 32 + 8 * fq;
                    const u32x4 xw = *(const u32x4*)(xr + c);
                    const f32x4 x0 = {bflo(xw.x), bfhi(xw.x), bflo(xw.y), bfhi(xw.y)}, x1 = {bflo(xw.z), bfhi(xw.z), bflo(xw.w), bfhi(xw.w)};
                    const f32x4 y0 = x0 * ALPHA + acc[ai][bj][m][0], y1 = x1 * ALPHA + acc[ai][bj][m][1];
                    u32x4 w; w.x = cvt_pk_bf16(y0[0], y0[1]); w.y = cvt_pk_bf16(y0[2], y0[3]); w.z = cvt_pk_bf16(y1[0], y1[1]); w.w = cvt_pk_bf16(y1[2], y1[3]);
                    *(u32x4*)(xr + c) = w;
                }
            }
    }
};
__device__ __forceinline__ float dpp_f(float oldv, float src, const int ctrl_sel) {
    const int o = __builtin_bit_cast(int, oldv), sv = __builtin_bit_cast(int, src); int r;
    if (ctrl_sel == 0) r = __builtin_amdgcn_update_dpp(o, sv, 0x121, 0xF, 0xF, false);
    else if (ctrl_sel == 1) r = __builtin_amdgcn_update_dpp(o, sv, 0x122, 0xF, 0xF, false);
    else if (ctrl_sel == 2) r = __builtin_amdgcn_update_dpp(o, sv, 0x111, 0xF, 0xF, false);
    else r = __builtin_amdgcn_update_dpp(o, sv, 0x112, 0xF, 0xF, false);
    return __builtin_bit_cast(float, r);
}
__device__ __forceinline__ float gelu_tanh_f(float x) {
    const float z = 0.7978845608028654f * (x + 0.044715f * x * x * x);
    const float th = 1.0f - 2.0f * __builtin_amdgcn_rcpf(1.0f + __expf(2.0f * z));
    return 0.5f * x * (1.0f + th);
}
struct EpiUp {
    static constexpr bool PERM = true;
    Params p; LAS float* xch;
    __device__ __forceinline__ void operator()(const f32x4 (&acc)[2][2][4][2], const Unit& u, int wr, int wc, int fr, int fq) const {
        u16* UV = (u16*)(p.ws + W_UV);
        const float* cw = p.in[17]; const float* cb = p.in[18]; const float* sc = p.in[7];
        const int ch0 = u.pn * 128 + wc * 32 + 8 * fq;
        if (fr >= 14) {
#pragma unroll
            for (int ai = 0; ai < 2; ++ai) { LAS float* d = xch + ((((ai * 2 + wr) * 4 + wc) * 2 + (fr & 1)) * 4 + fq) * 8;
                *(LAS f32x4*)d = acc[ai][0][3][0]; *(LAS f32x4*)(d + 4) = acc[ai][0][3][1]; }
        }
        asm volatile("s_waitcnt lgkmcnt(0)" ::: "memory");
        __builtin_amdgcn_s_barrier();
        const bool sample_tile = (u.pm >= 64 && u.pm < 68);
#pragma unroll
        for (int ai = 0; ai < 2; ++ai) {
            f32x4 pv0 = {0.f, 0.f, 0.f, 0.f}, pv1 = pv0;
            if (wr == 1 || ai == 1) { const int pa = (wr == 1) ? ai : 0, pw = (wr == 1) ? 0 : 1;
                LAS const float* d = xch + ((((pa * 2 + pw) * 4 + wc) * 2 + (fr & 1)) * 4 + fq) * 8; pv0 = *(LAS const f32x4*)d; pv1 = *(LAS const f32x4*)(d + 4); }
#pragma unroll
            for (int m = 0; m < 4; ++m) {
                const int row = u.pm * 256 + ai * 128 + wr * 64 + m * 16 + fr;
                float uu[8], vv[8], pp[8], u1[8], u2[8];
#pragma unroll
                for (int j = 0; j < 4; ++j) { uu[j] = acc[ai][0][m][0][j]; uu[4 + j] = acc[ai][0][m][1][j]; vv[j] = acc[ai][1][m][0][j]; vv[4 + j] = acc[ai][1][m][1][j];
                    pp[j] = (m == 0) ? pv0[j] : acc[ai][0][m > 0 ? m - 1 : 0][0][j]; pp[4 + j] = (m == 0) ? pv1[j] : acc[ai][0][m > 0 ? m - 1 : 0][1][j]; }
#pragma unroll
                for (int e = 0; e < 8; ++e) { u1[e] = dpp_f(dpp_f(0.f, pp[e], 0), uu[e], 2); u2[e] = dpp_f(dpp_f(0.f, pp[e], 1), uu[e], 3); }
                if (sample_tile) {
                    const int j8 = fr & 7, b = (row - ROW_S) >> 3;
                    if (j8 < 2) { const float* s1 = sc + ((size_t)b * 2 + 1) * DFF + ch0; const f32x4 a = *(const f32x4*)s1, c4 = *(const f32x4*)(s1 + 4);
                        if (j8 == 0) { const float* s0 = sc + ((size_t)b * 2) * DFF + ch0; const f32x4 a0 = *(const f32x4*)s0, c0 = *(const f32x4*)(s0 + 4);
#pragma unroll
                            for (int j = 0; j < 4; ++j) { u1[j] = a[j]; u1[4 + j] = c4[j]; u2[j] = a0[j]; u2[4 + j] = c0[j]; } }
                        else {
#pragma unroll
                            for (int j = 0; j < 4; ++j) { u2[j] = a[j]; u2[4 + j] = c4[j]; } } }
                }
                if (row < MROWS) {
                    const f32x4 w0a = *(const f32x4*)(cw + ch0), w0b = *(const f32x4*)(cw + ch0 + 4), w1a = *(const f32x4*)(cw + DFF + ch0), w1b = *(const f32x4*)(cw + DFF + ch0 + 4),
                                w2a = *(const f32x4*)(cw + 2 * DFF + ch0), w2b = *(const f32x4*)(cw + 2 * DFF + ch0 + 4), ba = *(const f32x4*)(cb + ch0), bb = *(const f32x4*)(cb + ch0 + 4);
                    float hv[8];
#pragma unroll
                    for (int e = 0; e < 8; ++e) { const float w0 = e < 4 ? w0a[e & 3] : w0b[e & 3], w1 = e < 4 ? w1a[e & 3] : w1b[e & 3], w2 = e < 4 ? w2a[e & 3] : w2b[e & 3], b0 = e < 4 ? ba[e & 3] : bb[e & 3];
                        hv[e] = gelu_tanh_f(b0 + w0 * u2[e] + w1 * u1[e] + w2 * uu[e]) * vv[e]; }
                    *(u32x4*)(UV + (size_t)row * UVW + DFF + ch0) = pack8(hv);
                    float* fo = nullptr;
                    if (row >= ROW_S && row < ROW_M) { const int s2 = row - ROW_S; if ((s2 & 7) >= 6) fo = p.out + O_CONVS + ((size_t)(s2 >> 3) * 2 + ((s2 & 7) - 6)) * DFF; }
                    else if (row >= NPR - 2 && row < NPR) fo = p.out + O_CONVP + (size_t)(row - (NPR - 2)) * DFF;
                    if (fo) { *(f32x4*)(fo + ch0) = acc[ai][0][m][0]; *(f32x4*)(fo + ch0 + 4) = acc[ai][0][m][1]; }
                    if (ai == 1 && wr == 1 && m == 3 && fr >= 14 && u.pm < 64) *(u32x4*)((u16*)(p.ws + W_HALO) + ((size_t)u.pm * 2 + (fr & 1)) * DFF + ch0) = pack8(uu);
                    if (ai == 0 && wr == 0 && m == 0) {
                        if (u.pm == 68 && fr >= 14) *(u32x4*)((u16*)(p.ws + W_HALO) + ((size_t)69 * 2 + (fr & 1)) * DFF + ch0) = pack8(uu);
                        if (u.pm < 64 && fr < 2) { *(u32x4*)((u16*)(p.ws + W_FIXU) + ((size_t)u.pm * 2 + fr) * DFF + ch0) = pack8(uu); *(u32x4*)((u16*)(p.ws + W_FIXV) + ((size_t)u.pm * 2 + fr) * DFF + ch0) = pack8(vv); }
                    }
                }
            }
        }
    }
};

__device__ __forceinline__ void meta_inproj(const Params& p, int bid, int w, int lane, int G) {
    const int fr = lane & 15, fq = lane >> 4;
    const u16* Xb = (const u16*)((const unsigned char*)p.out + OB_XB) + (size_t)(ROW_M + fr) * DM + fq * 8;
    const float* lb = (const float*)(p.ws + W_LB);
    for (int tile = w * G + bid; tile < INC / 16; tile += 8 * G) {
        const u16* Wr = (const u16*)(p.ws + W_WIN) + (size_t)(tile * 16 + fr) * DM + fq * 8;
        f32x4 a = {0.f, 0.f, 0.f, 0.f};
#pragma unroll 8
        for (int ks = 0; ks < 32; ++ks) {
            const bf16x8 bw = *(const bf16x8*)(Wr + ks * 32), ax = *(const bf16x8*)(Xb + ks * 32);
            a = __builtin_amdgcn_mfma_f32_16x16x32_bf16(bw, ax, a, 0, 0, 0);
        }
        const int col = tile * 16 + fq * 4, row = ROW_M + fr;
        float v[4] = {a[0], a[1], a[2], a[3]};
        u16* dst;
        if (col < 1024) { dst = (u16*)((unsigned char*)p.out + OB_Q) + (size_t)row * 1024 + col;
#pragma unroll
            for (int j = 0; j < 4; ++j) v[j] *= 0.125f; }
        else if (col < 1536) { dst = (u16*)((unsigned char*)p.out + OB_KV) + (size_t)row * 512 + (col - 1024);
            float* fo = p.out + (col < 1280 ? O_METAK : O_METAV) + (size_t)fr * 256 + (col & 255);
            *(f32x4*)fo = (f32x4){v[0], v[1], v[2], v[3]}; }
        else { const int g = (col - 1536) >> 10, c = (col - 1536) & 1023; dst = (u16*)(p.ws + W_S1 + (size_t)g * SLOT) + (size_t)row * 1024 + c;
            if (g == 1) { const f32x4 l4 = *(const f32x4*)(lb + c); unsigned hh[4];
#pragma unroll
                for (int j = 0; j < 4; ++j) { const float f = l4[j] + (1.0f - l4[j]) * sigmoidf_(v[j]); hh[j] = f2h(__logf(f)); }
                u32x2 wv; wv.x = hh[0] | (hh[1] << 16); wv.y = hh[2] | (hh[3] << 16); *(u32x2*)dst = wv; continue; } }
        u32x2 wv; wv.x = cvt_pk_bf16(v[0], v[1]); wv.y = cvt_pk_bf16(v[2], v[3]); *(u32x2*)dst = wv;
    }
}

__device__ __forceinline__ void transpose_tile(const float* W, int K, int N, u16* Wt, int tile, LAS float* sm, bool perm_up = false) {
    const int ntn = N / 64, tk = tile / ntn, tn = tile % ntn, tid = threadIdx.x;
    const int n0 = tn * 64, ch0 = n0 % DFF, nout = perm_up ? (ch0 / 128) * 256 + (ch0 % 128) + (n0 >= DFF ? 128 : 0) : n0;
#pragma unroll
    for (int i = 0; i < 8; ++i) { const int k = i * 8 + (tid >> 6), n = tid & 63; sm[k * 65 + n] = W[(size_t)(tk * 64 + k) * N + tn * 64 + n]; }
    __syncthreads();
    { const int n = tid >> 3, kg = tid & 7; float v[8];
#pragma unroll
      for (int j = 0; j < 8; ++j) v[j] = sm[(kg * 8 + j) * 65 + n];
      *(u32x4*)(Wt + (size_t)(nout + n) * K + tk * 64 + kg * 8) = pack8(v); }
    __syncthreads();
}

struct TDesc { const float* W; u16* Wt; int K, N, tile; bool perm, valid; };
__device__ __forceinline__ void transpose4(const TDesc (&d)[4], LAS float* sm) {
    const int tid = threadIdx.x;
    float r[4][8];
#pragma unroll
    for (int q = 0; q < 4; ++q) if (d[q].valid) { const int ntn = d[q].N / 64, tk = d[q].tile / ntn, tn = d[q].tile % ntn;
#pragma unroll
        for (int i = 0; i < 8; ++i) r[q][i] = __builtin_nontemporal_load(d[q].W + (size_t)(tk * 64 + i * 8 + (tid >> 6)) * d[q].N + tn * 64 + (tid & 63)); }
#pragma unroll
    for (int q = 0; q < 4; ++q) if (d[q].valid) {
#pragma unroll
        for (int i = 0; i < 8; ++i) sm[q * 4160 + (i * 8 + (tid >> 6)) * 65 + (tid & 63)] = r[q][i]; }
    __syncthreads();
#pragma unroll
    for (int q = 0; q < 4; ++q) if (d[q].valid) { const int ntn = d[q].N / 64, tk = d[q].tile / ntn, tn = d[q].tile % ntn;
        const int n0 = tn * 64, ch0 = n0 % DFF, nout = d[q].perm ? (ch0 / 128) * 256 + (ch0 % 128) + (n0 >= DFF ? 128 : 0) : n0;
        const int n = tid >> 3, kg = tid & 7; float v[8];
#pragma unroll
        for (int j = 0; j < 8; ++j) v[j] = sm[q * 4160 + (kg * 8 + j) * 65 + n];
        *(u32x4*)(d[q].Wt + (size_t)(nout + n) * d[q].K + tk * 64 + kg * 8) = pack8(v); }
    __syncthreads();
}

constexpr int KS_LD = 72, VT_LD = 296, NSLOT = 288;
constexpr int ATT_KS = 0, ATT_VT = NSLOT * KS_LD * 2, ATT_P = ATT_VT + 64 * VT_LD * 2;
static_assert(ATT_P + 8 * 16 * VT_LD * 2 <= LDS_BYTES, "attention LDS");

__device__ __forceinline__ void attn_rowtile(LAS const u16* Ks, LAS const u16* Vt, LAS u16* Pw, const u16* qptr, u16* optr,
                                             int tq, int meta_lim, int bs_min, int bs_max, int kk1, float sink, int lane) {
    const int fr = lane & 15, fq = lane >> 4;
    bf16x8 qf0 = *(const bf16x8*)(qptr + fq * 8), qf1 = *(const bf16x8*)(qptr + 32 + fq * 8);
    f32x4 s[12];
#pragma unroll
    for (int i = 0; i < 12; ++i) {
        const int tile = (i < 2) ? i : 2 * kk1 + (i - 2);
        LAS const u16* kr = Ks + (tile * 16 + fr) * KS_LD + fq * 8;
        const bf16x8 k0 = *(LAS const bf16x8*)kr, k1 = *(LAS const bf16x8*)(kr + 32);
        f32x4 a = {0.f, 0.f, 0.f, 0.f};
        a = __builtin_amdgcn_mfma_f32_16x16x32_bf16(k0, qf0, a, 0, 0, 0);
        a = __builtin_amdgcn_mfma_f32_16x16x32_bf16(k1, qf1, a, 0, 0, 0);
        s[i] = a;
    }
    float mx = sink;
#pragma unroll
    for (int i = 0; i < 12; ++i) {
        const int tile = (i < 2) ? i : 2 * kk1 + (i - 2);
#pragma unroll
        for (int jj = 0; jj < 4; ++jj) {
            const int slot = tile * 16 + fq * 4 + jj, bs = slot - 16;
            const bool vis = (slot < 16) ? (slot <= meta_lim) : (bs > tq && bs <= tq + 128 && bs >= bs_min && bs < bs_max);
            const float v = vis ? s[i][jj] : -1e30f; s[i][jj] = v; mx = fmaxf(mx, v);
        }
    }
    mx = fmaxf(mx, __shfl_xor(mx, 16)); mx = fmaxf(mx, __shfl_xor(mx, 32));
    float sum = 0.f;
#pragma unroll
    for (int i = 0; i < 12; ++i) {
        const int tile = (i < 2) ? i : 2 * kk1 + (i - 2);
        float pv[4];
#pragma unroll
        for (int jj = 0; jj < 4; ++jj) { pv[jj] = __expf(s[i][jj] - mx); sum += pv[jj]; }
        u32x2 w; w.x = cvt_pk_bf16(pv[0], pv[1]); w.y = cvt_pk_bf16(pv[2], pv[3]);
        *(LAS u32x2*)(Pw + fr * VT_LD + tile * 16 + fq * 4) = w;
    }
    sum += __shfl_xor(sum, 16); sum += __shfl_xor(sum, 32);
    const float inv = __builtin_amdgcn_rcpf(sum + __expf(sink - mx));
    asm volatile("s_waitcnt lgkmcnt(0)" ::: "memory"); __builtin_amdgcn_wave_barrier();
    f32x4 o[4];
#pragma unroll
    for (int dt = 0; dt < 4; ++dt) o[dt] = (f32x4){0.f, 0.f, 0.f, 0.f};
#pragma unroll
    for (int ks = 0; ks < 6; ++ks) {
        const int kk = (ks == 0) ? 0 : kk1 + ks - 1;
        const bf16x8 pf = *(LAS const bf16x8*)(Pw + fr * VT_LD + kk * 32 + fq * 8);
#pragma unroll
        for (int dt = 0; dt < 4; ++dt) {
            const bf16x8 vf = *(LAS const bf16x8*)(Vt + (dt * 16 + fr) * VT_LD + kk * 32 + fq * 8);
            o[dt] = __builtin_amdgcn_mfma_f32_16x16x32_bf16(vf, pf, o[dt], 0, 0, 0);
        }
    }
#pragma unroll
    for (int dt = 0; dt < 4; ++dt) {
        u32x2 w; w.x = cvt_pk_bf16(o[dt][0] * inv, o[dt][1] * inv); w.y = cvt_pk_bf16(o[dt][2] * inv, o[dt][3] * inv);
        *(u32x2*)(optr + dt * 16 + fq * 4) = w;
    }
    asm volatile("s_waitcnt lgkmcnt(0)" ::: "memory"); __builtin_amdgcn_wave_barrier();
}

__device__ __forceinline__ u32x4 kv_load8(const Params& p, int mode, int nb, int kvh, int slot, int dg, int isV) {
    const u16* KV = (const u16*)((const unsigned char*)p.out + OB_KV);
    const u32x4 z = {0u, 0u, 0u, 0u};
    if (mode == 0) {
        int row;
        if (slot < 16) row = ROW_M + slot;
        else if (slot < 272) { row = 128 * (nb - 2) + (slot - 16); if (nb < 1 || row < 0) return z; }
        else return z;
        return *(const u32x4*)(KV + (size_t)row * 512 + isV * 256 + kvh * 64 + dg * 8);
    } else {
        if (slot < 144) {
            const float* src = (slot < 16) ? p.in[2 + isV] + ((size_t)(nb * 16 + slot) * 4 + kvh) * 64 + dg * 8
                                           : p.in[4 + isV] + ((size_t)(nb * 128 + slot - 16) * 4 + kvh) * 64 + dg * 8;
            const f32x4 a = __builtin_nontemporal_load((const f32x4*)src), b = __builtin_nontemporal_load((const f32x4*)(src + 4));
            u32x4 w; w.x = cvt_pk_bf16(a[0], a[1]); w.y = cvt_pk_bf16(a[2], a[3]); w.z = cvt_pk_bf16(b[0], b[1]); w.w = cvt_pk_bf16(b[2], b[3]); return w;
        } else if (slot < 152) {
            return *(const u32x4*)(KV + (size_t)(ROW_S + nb * 8 + slot - 144) * 512 + isV * 256 + kvh * 64 + dg * 8);
        }
        return z;
    }
}

__device__ __forceinline__ void attn_load(const Params& p, int mode, int nb, int kvh, int nslots, u32x4 (&k)[5], u32x4 (&va)[3], u32x4 (&vb)[3]) {
    const int tid = threadIdx.x, np = nslots >> 1;
#pragma unroll
    for (int i = 0; i < 5; ++i) { const int c = tid + i * 512; if (c < nslots * 8) k[i] = kv_load8(p, mode, nb, kvh, c >> 3, c & 7, 0); }
#pragma unroll
    for (int i = 0; i < 3; ++i) { const int c = tid + i * 512; if (c < np * 8) { const int pr = c % np, dg = c / np;
        va[i] = kv_load8(p, mode, nb, kvh, 2 * pr, dg, 1); vb[i] = kv_load8(p, mode, nb, kvh, 2 * pr + 1, dg, 1); } }
}
__device__ __forceinline__ void attn_store(LAS unsigned char* lds, int nslots, const u32x4 (&k)[5], const u32x4 (&va)[3], const u32x4 (&vb)[3]) {
    LAS u16* Ks = (LAS u16*)(lds + ATT_KS); LAS u16* Vt = (LAS u16*)(lds + ATT_VT);
    const int tid = threadIdx.x, np = nslots >> 1;
#pragma unroll
    for (int i = 0; i < 5; ++i) { const int c = tid + i * 512; if (c < nslots * 8) *(LAS u32x4*)(Ks + (c >> 3) * KS_LD + (c & 7) * 8) = k[i]; }
#pragma unroll
    for (int i = 0; i < 3; ++i) { const int c = tid + i * 512; if (c < np * 8) { const int pr = c % np, dg = c / np;
        const u32x4 a = va[i], b = vb[i];
        LAS u16* d = Vt + (dg * 8) * VT_LD + 2 * pr;
        *(LAS unsigned*)(d + 0 * VT_LD) = (a.x & 0xffffu) | (b.x << 16);  *(LAS unsigned*)(d + 1 * VT_LD) = (a.x >> 16) | (b.x & 0xffff0000u);
        *(LAS unsigned*)(d + 2 * VT_LD) = (a.y & 0xffffu) | (b.y << 16);  *(LAS unsigned*)(d + 3 * VT_LD) = (a.y >> 16) | (b.y & 0xffff0000u);
        *(LAS unsigned*)(d + 4 * VT_LD) = (a.z & 0xffffu) | (b.z << 16);  *(LAS unsigned*)(d + 5 * VT_LD) = (a.z >> 16) | (b.z & 0xffff0000u);
        *(LAS unsigned*)(d + 6 * VT_LD) = (a.w & 0xffffu) | (b.w << 16);  *(LAS unsigned*)(d + 7 * VT_LD) = (a.w >> 16) | (b.w & 0xffff0000u); } }
}

__device__ __forceinline__ void attn_prompt_items(const Params& p, LAS unsigned char* lds, int bid, int G) {
    const int tid = threadIdx.x, lane = tid & 63, w = __builtin_amdgcn_readfirstlane(tid >> 6), fr = lane & 15;
    LAS const u16* Ks = (LAS const u16*)(lds + ATT_KS); LAS const u16* Vt = (LAS const u16*)(lds + ATT_VT);
    LAS u16* Pw = (LAS u16*)(lds + ATT_P) + w * 16 * VT_LD;
    u16* Q = (u16*)((unsigned char*)p.out + OB_Q);
    u32x4 k[5], va[3], vb[3];
    int it = bid;
    if (it >= 516) return;
#define ATT_MAP(it_, nb_, kvh_) do { if ((it_) < 512) { const int x_ = bid & 7, j_ = bid >> 3, k_ = (it_) >> 8; kvh_ = x_ & 3; nb_ = 1 + 64 * (x_ >> 2) + 2 * j_ + k_; } else { nb_ = 0; kvh_ = (it_) & 3; } } while (0)
    { int nb, kvh; ATT_MAP(it, nb, kvh); attn_load(p, 0, nb, kvh, nb == 0 ? 192 : NSLOT, k, va, vb); }
    for (; it < 516; it += G) {
        int nb, kvh; ATT_MAP(it, nb, kvh);
        attn_store(lds, nb == 0 ? 192 : NSLOT, k, va, vb);
        __syncthreads();
        { const int nx = it + G; if (nx < 516) { int nb2, kvh2; ATT_MAP(nx, nb2, kvh2); attn_load(p, 0, nb2, kvh2, nb2 == 0 ? 192 : NSLOT, k, va, vb); } }
        if (nb > 0) {
            const int ts = w, tq = ts * 16 + fr, row = 128 * (nb - 1) + tq, kk1 = max(1, (1 + ts) >> 1);
            for (int gq = 0; gq < 4; ++gq) {
                const int head = kvh * 4 + gq;
                u16* qp = Q + (size_t)row * DM + head * 64;
                attn_rowtile(Ks, Vt, Pw, qp, qp, tq, 15, nb >= 2 ? 0 : 128, 256, kk1, p.in[10][head], lane);
            }
        } else if (w < 4) {
            const int head = kvh * 4 + w;
            u16* qp = Q + (size_t)(ROW_M + fr) * DM + head * 64;
            attn_rowtile(Ks, Vt, Pw, qp, qp, fr, fr, 128, 0, 1, p.in[10][head], lane);
        }
        __syncthreads();
    }
}
__device__ __forceinline__ void attn_sample_items(const Params& p, LAS unsigned char* lds, int bid, int G) {
    const int tid = threadIdx.x, lane = tid & 63, w = __builtin_amdgcn_readfirstlane(tid >> 6), fr = lane & 15;
    LAS const u16* Ks = (LAS const u16*)(lds + ATT_KS); LAS const u16* Vt = (LAS const u16*)(lds + ATT_VT);
    LAS u16* Pw = (LAS u16*)(lds + ATT_P) + w * 16 * VT_LD;
    u16* Q = (u16*)((unsigned char*)p.out + OB_Q);
    u32x4 k[5], va[3], vb[3];
    int it = bid;
    if (it >= 512) return;
    attn_load(p, 1, it >> 2, it & 3, 192, k, va, vb);
    for (; it < 512; it += G) {
        const int b = it >> 2, kvh = it & 3;
        attn_store(lds, 192, k, va, vb);
        __syncthreads();
        { const int nx = it + G; if (nx < 512) attn_load(p, 1, nx >> 2, nx & 3, 192, k, va, vb); }
        if (w < 2) {
            const int head = kvh * 4 + w * 2 + (fr >> 3), j = fr & 7;
            u16* qp = Q + (size_t)(ROW_S + b * 8 + j) * DM + head * 64;
            attn_rowtile(Ks, Vt, Pw, qp, qp, j, 15, 0, 136, 1, p.in[10][head], lane);
        }
        __syncthreads();
    }
}

constexpr int HQ_LD = 136, HK_LD = 72;
constexpr int H_QD = 0, H_KD = H_QD + 64 * HQ_LD * 2, H_KE = H_KD + 64 * HQ_LD * 2, H_VT = H_KE + 128 * HK_LD * 2, H_PM = H_VT + 128 * HK_LD * 2,
              H_ST = H_PM + 64 * HK_LD * 2, H_SEG = H_ST + 128 * HQ_LD * 2, H_DEC = H_SEG + 4096, H_LF = H_DEC + 512, H_END = H_LF + 64 * 128 * 4;
constexpr int H_VR = H_ST;
static_assert(H_END <= LDS_BYTES - 16, "hgrn LDS");

template <bool L3>
__device__ __forceinline__ void hgrn_prompt_item(const Params& p, LAS unsigned char* lds, int g, int h) {
    const int tid = threadIdx.x, lane = tid & 63, w = __builtin_amdgcn_readfirstlane(tid >> 6), fr = lane & 15, fq = lane >> 4;
    LAS u16* QD = (LAS u16*)(lds + H_QD); LAS u16* KD = (LAS u16*)(lds + H_KD); LAS u16* KEt = (LAS u16*)(lds + H_KE); LAS u16* Vt = (LAS u16*)(lds + H_VT);
    LAS u16* Pm = (LAS u16*)(lds + H_PM); LAS u16* St = (LAS u16*)(lds + H_ST); LAS float* segt = (LAS float*)(lds + H_SEG); LAS float* decs = (LAS float*)(lds + H_DEC);
    u16* HQ = (u16*)(p.ws + W_S1); const u16* LF = (const u16*)(p.ws + W_S2); const u16* HV = (const u16*)(p.ws + W_S3);
    float* Lb = (float*)(p.ws + W_L); float* Dg = (float*)(p.ws + W_DG);
    f32x4 S[8];
#pragma unroll
    for (int it = 0; it < 8; ++it) S[it] = (f32x4){0.f, 0.f, 0.f, 0.f};
    float gsum0 = 0.f, gsum1 = 0.f;
    if (L3) {
        const float* Lp = Lb + ((size_t)((g * 8 + h) * 8 + w) * 8) * 256;
#pragma unroll
        for (int it = 0; it < 8; ++it) S[it] = *(const f32x4*)(Lp + (it * 64 + lane) * 4);
    }
    LAS float* lfS = (LAS float*)(lds + H_LF); LAS u16* Vraw = (LAS u16*)(lds + H_VR);
    const int nchunks = (g == 0) ? 9 : 8;
#define HG_CHUNK_ROWS(ci_, r0_, nv_) do { if (g == 0) { if ((ci_) == 0) { r0_ = ROW_M; nv_ = 16; } else { r0_ = ((ci_) - 1) * 64; nv_ = 64; } } else { r0_ = g * 512 + (ci_) * 64; nv_ = 64; } } while (0)
    u32x4 pLF[2], pHV[2], pHQ[2];
#define HG_PREFETCH(ci_) do { int r0n_, nvn_; HG_CHUNK_ROWS(ci_, r0n_, nvn_); _Pragma("unroll") for (int rep = 0; rep < 2; ++rep) { \
        const int t_ = (tid >> 4) + rep * 32, c8_ = (tid & 15) * 8; const bool ok_ = t_ < nvn_; const size_t ga_ = (size_t)(r0n_ + t_) * DM + h * 128 + c8_; \
        const u32x4 z4_ = {0u, 0u, 0u, 0u}; pLF[rep] = ok_ ? *(const u32x4*)(LF + ga_) : z4_; pHV[rep] = ok_ ? *(const u32x4*)(HV + ga_) : z4_; \
        if (L3) pHQ[rep] = ok_ ? *(const u32x4*)(HQ + ga_) : z4_; } } while (0)
    HG_PREFETCH(0);
    for (int ci = 0; ci < nchunks; ++ci) {
        int r0, nvalid;
        HG_CHUNK_ROWS(ci, r0, nvalid);
#pragma unroll
        for (int rep = 0; rep < 2; ++rep) {
            const int t = (tid >> 4) + rep * 32, c8 = (tid & 15) * 8;
            const u32x4 lw = pLF[rep];
            f32x4 l0, l1;
            l0[0] = h2f((u16)(lw.x & 0xffffu)); l0[1] = h2f((u16)(lw.x >> 16)); l0[2] = h2f((u16)(lw.y & 0xffffu)); l0[3] = h2f((u16)(lw.y >> 16));
            l1[0] = h2f((u16)(lw.z & 0xffffu)); l1[1] = h2f((u16)(lw.z >> 16)); l1[2] = h2f((u16)(lw.w & 0xffffu)); l1[3] = h2f((u16)(lw.w >> 16));
            *(LAS f32x4*)(lfS + t * 128 + c8) = l0; *(LAS f32x4*)(lfS + t * 128 + c8 + 4) = l1;
            *(LAS u32x4*)(Vraw + t * 128 + c8) = pHV[rep];
            if (L3) *(LAS u32x4*)(QD + t * HQ_LD + c8) = pHQ[rep];
        }
        if (ci + 1 < nchunks) HG_PREFETCH(ci + 1);
        __syncthreads();
        {
            typedef float f32x2v __attribute__((ext_vector_type(2)));
            const int dk0 = (tid & 63) * 2, seg = tid >> 6;
            float lf0[8], lf1[8]; float run0 = 0.f, run1 = 0.f;
#pragma unroll
            for (int i = 0; i < 8; ++i) { const f32x2v l = *(LAS const f32x2v*)(lfS + (seg * 8 + i) * 128 + dk0); lf0[i] = l.x; lf1[i] = l.y; run0 += l.x; run1 += l.y; }
            *(LAS f32x2v*)(segt + seg * 128 + dk0) = (f32x2v){run0, run1};
            __syncthreads();
            float off0 = 0.f, off1 = 0.f, tot0 = 0.f, tot1 = 0.f;
#pragma unroll
            for (int s2 = 0; s2 < 8; ++s2) { const f32x2v v = *(LAS const f32x2v*)(segt + s2 * 128 + dk0); tot0 += v.x; tot1 += v.y; off0 += (s2 < seg) ? v.x : 0.f; off1 += (s2 < seg) ? v.y : 0.f; }
            gsum0 += tot0; gsum1 += tot1;
            if (seg == 0) *(LAS f32x2v*)(decs + dk0) = (f32x2v){__expf(tot0), __expf(tot1)};
            float b0 = off0, b1 = off1; unsigned ke0[4], ke1[4], vv0[4], vv1[4];
#pragma unroll
            for (int i = 0; i < 8; ++i) {
                const int t = seg * 8 + i; const bool ok = t < nvalid;
                b0 += lf0[i]; b1 += lf1[i];
                const float k0 = ok ? 1.0f - __expf(lf0[i]) : 0.f, k1 = ok ? 1.0f - __expf(lf1[i]) : 0.f;
                const unsigned e0 = f2bf(k0 * __expf(tot0 - b0)), e1 = f2bf(k1 * __expf(tot1 - b1));
                const unsigned vw = *(LAS const unsigned*)(Vraw + t * 128 + dk0);
                if (i & 1) { ke0[i >> 1] |= e0 << 16; ke1[i >> 1] |= e1 << 16; vv0[i >> 1] |= vw << 16; vv1[i >> 1] |= vw & 0xffff0000u; }
                else { ke0[i >> 1] = e0; ke1[i >> 1] = e1; vv0[i >> 1] = vw & 0xffffu; vv1[i >> 1] = vw >> 16; }
                if (L3) {
                    *(LAS unsigned*)(KD + t * HQ_LD + dk0) = cvt_pk_bf16(k0 * __expf(-b0), k1 * __expf(-b1));
                    const unsigned qw = *(LAS const unsigned*)(QD + t * HQ_LD + dk0);
                    const float q0 = bflo(qw), q1 = bfhi(qw);
                    *(LAS unsigned*)(QD + t * HQ_LD + dk0) = cvt_pk_bf16(q0 * sigmoidf_(q0) * __expf(b0), q1 * sigmoidf_(q1) * __expf(b1));
                }
            }
            *(LAS u32x4*)(KEt + dk0 * HK_LD + seg * 8) = (u32x4){ke0[0], ke0[1], ke0[2], ke0[3]};
            *(LAS u32x4*)(KEt + (dk0 + 1) * HK_LD + seg * 8) = (u32x4){ke1[0], ke1[1], ke1[2], ke1[3]};
            *(LAS u32x4*)(Vt + dk0 * HK_LD + seg * 8) = (u32x4){vv0[0], vv0[1], vv0[2], vv0[3]};
            *(LAS u32x4*)(Vt + (dk0 + 1) * HK_LD + seg * 8) = (u32x4){vv1[0], vv1[1], vv1[2], vv1[3]};
        }
        __syncthreads();
        bf16x8 vf[2];
#pragma unroll
        for (int ks = 0; ks < 2; ++ks) vf[ks] = *(LAS const bf16x8*)(Vt + (w * 16 + fr) * HK_LD + ks * 32 + fq * 8);
        if (L3) {
            const int tt = w >> 1;
#pragma unroll
            for (int si = 0; si < 2; ++si) {
                const int st = 2 * (w & 1) + si;
                f32x4 a = {0.f, 0.f, 0.f, 0.f};
                if (st <= tt) {
#pragma unroll
                    for (int ks = 0; ks < 4; ++ks) {
                        const bf16x8 kf = *(LAS const bf16x8*)(KD + (st * 16 + fr) * HQ_LD + ks * 32 + fq * 8);
                        const bf16x8 qf = *(LAS const bf16x8*)(QD + (tt * 16 + fr) * HQ_LD + ks * 32 + fq * 8);
                        a = __builtin_amdgcn_mfma_f32_16x16x32_bf16(kf, qf, a, 0, 0, 0);
                    }
                }
                const int t = tt * 16 + fr, s0 = st * 16 + fq * 4;
                u32x2 wv; wv.x = cvt_pk_bf16(s0 <= t ? a[0] : 0.f, s0 + 1 <= t ? a[1] : 0.f); wv.y = cvt_pk_bf16(s0 + 2 <= t ? a[2] : 0.f, s0 + 3 <= t ? a[3] : 0.f);
                *(LAS u32x2*)(Pm + t * HK_LD + s0) = wv;
            }
#pragma unroll
            for (int it = 0; it < 8; ++it) { u32x2 wv; wv.x = cvt_pk_bf16(S[it][0], S[it][1]); wv.y = cvt_pk_bf16(S[it][2], S[it][3]);
                *(LAS u32x2*)(St + (w * 16 + fr) * HQ_LD + it * 16 + fq * 4) = wv; }
            __syncthreads();
            bf16x8 sf[4];
#pragma unroll
            for (int ks = 0; ks < 4; ++ks) sf[ks] = *(LAS const bf16x8*)(St + (w * 16 + fr) * HQ_LD + ks * 32 + fq * 8);
#pragma unroll
            for (int tt2 = 0; tt2 < 4; ++tt2) {
                f32x4 o = {0.f, 0.f, 0.f, 0.f};
#pragma unroll
                for (int ks = 0; ks < 2; ++ks) { const bf16x8 pf = *(LAS const bf16x8*)(Pm + (tt2 * 16 + fr) * HK_LD + ks * 32 + fq * 8); o = __builtin_amdgcn_mfma_f32_16x16x32_bf16(vf[ks], pf, o, 0, 0, 0); }
#pragma unroll
                for (int ks = 0; ks < 4; ++ks) { const bf16x8 qf = *(LAS const bf16x8*)(QD + (tt2 * 16 + fr) * HQ_LD + ks * 32 + fq * 8); o = __builtin_amdgcn_mfma_f32_16x16x32_bf16(sf[ks], qf, o, 0, 0, 0); }
                const int t = tt2 * 16 + fr;
                if (t < nvalid) { u32x2 wv; wv.x = cvt_pk_bf16(o[0], o[1]); wv.y = cvt_pk_bf16(o[2], o[3]); *(u32x2*)(HQ + (size_t)(r0 + t) * DM + h * 128 + w * 16 + fq * 4) = wv; }
            }
        }
#pragma unroll
        for (int it = 0; it < 8; ++it) {
            const f32x4 d = *(LAS const f32x4*)(decs + it * 16 + fq * 4);
            f32x4 a = S[it] * d;
#pragma unroll
            for (int ks = 0; ks < 2; ++ks) { const bf16x8 kf = *(LAS const bf16x8*)(KEt + (it * 16 + fr) * HK_LD + ks * 32 + fq * 8); a = __builtin_amdgcn_mfma_f32_16x16x32_bf16(kf, vf[ks], a, 0, 0, 0); }
            S[it] = a;
        }
        __syncthreads();
    }
    if (!L3) {
        float* Lp = Lb + ((size_t)((g * 8 + h) * 8 + w) * 8) * 256;
#pragma unroll
        for (int it = 0; it < 8; ++it) *(f32x4*)(Lp + (it * 64 + lane) * 4) = S[it];
        if (tid < 64) { Dg[(g * 8 + h) * 128 + 2 * tid] = __expf(gsum0); Dg[(g * 8 + h) * 128 + 2 * tid + 1] = __expf(gsum1); }
    } else if (g == 31) {
        float* o = p.out + O_HGP + (size_t)h * 16384;
#pragma unroll
        for (int it = 0; it < 8; ++it)
#pragma unroll
            for (int jj = 0; jj < 4; ++jj) o[(it * 16 + fq * 4 + jj) * 128 + w * 16 + fr] = S[it][jj];
    }
}

#undef HG_CHUNK_ROWS
#undef HG_PREFETCH
__device__ __forceinline__ void hgrn_sample_item(const Params& p, LAS unsigned char* lds, int b, int h) {
    const int tid = threadIdx.x;
    LAS float* qS = (LAS float*)lds; LAS float* dS = qS + 1024; LAS float* vS = dS + 1024; LAS float* part = vS + 1024;
    u16* HQ = (u16*)(p.ws + W_S1); const u16* LF = (const u16*)(p.ws + W_S2); const u16* HV = (const u16*)(p.ws + W_S3);
    const int dvq = tid & 31, dkg = tid >> 5;
    const float* s0 = p.in[6] + ((size_t)(b * 8 + h) * 128) * 128;
    f32x4 S[8];
#pragma unroll
    for (int i = 0; i < 8; ++i) S[i] = __builtin_nontemporal_load((const f32x4*)(s0 + (size_t)(dkg + 16 * i) * 128 + 4 * dvq));
    if (tid < 384) {
        const int arr = tid >> 7, j = (tid & 127) >> 4, c8 = (tid & 15) * 8; const size_t a = (size_t)(ROW_S + b * 8 + j) * DM + h * 128 + c8;
        const u32x4 w = *(const u32x4*)((arr == 0 ? LF : (arr == 1 ? (const u16*)HQ : HV)) + a);
        float f[8];
#pragma unroll
        for (int e = 0; e < 4; ++e) { const unsigned lo = w[e] & 0xffffu, hi = w[e] >> 16;
            if (arr == 0) { f[2 * e] = __expf(h2f((u16)lo)); f[2 * e + 1] = __expf(h2f((u16)hi)); }
            else if (arr == 1) { const float q0 = bf2f((u16)lo), q1 = bf2f((u16)hi); f[2 * e] = q0 * sigmoidf_(q0); f[2 * e + 1] = q1 * sigmoidf_(q1); }
            else { f[2 * e] = bf2f((u16)lo); f[2 * e + 1] = bf2f((u16)hi); } }
        LAS float* dst = (arr == 0 ? dS : (arr == 1 ? qS : vS)) + j * 128 + c8;
        *(LAS f32x4*)dst = (f32x4){f[0], f[1], f[2], f[3]}; *(LAS f32x4*)(dst + 4) = (f32x4){f[4], f[5], f[6], f[7]};
    }
    __syncthreads();
#pragma unroll
    for (int j = 0; j < 8; ++j) {
        const f32x4 v = *(LAS const f32x4*)(vS + j * 128 + 4 * dvq);
        f32x4 acc = {0.f, 0.f, 0.f, 0.f};
#pragma unroll
        for (int i = 0; i < 8; ++i) { const int dk = dkg + 16 * i; const float de = dS[j * 128 + dk], q = qS[j * 128 + dk]; const float k = 1.0f - de;
            S[i] = S[i] * de + v * k; acc += S[i] * q; }
        *(LAS f32x4*)(part + (j * 16 + dkg) * 128 + 4 * dvq) = acc;
    }
    float* so = p.out + O_HGS + ((size_t)(b * 8 + h) * 128) * 128;
#pragma unroll
    for (int i = 0; i < 8; ++i) __builtin_nontemporal_store(S[i], (f32x4*)(so + (size_t)(dkg + 16 * i) * 128 + 4 * dvq));
    __syncthreads();
    for (int idx = tid; idx < 1024; idx += 512) { const int j = idx >> 7, d = idx & 127; float s = 0.f;
#pragma unroll
        for (int k2 = 0; k2 < 16; ++k2) s += part[(j * 16 + k2) * 128 + d];
        HQ[(size_t)(ROW_S + b * 8 + j) * DM + h * 128 + d] = f2bf(s); }
    __syncthreads();
}

template <bool FIRST, int NB>
__device__ __forceinline__ void ln_rows(const Params& p, int rowb, int rstride, int lane, const float* gam, const float* bet) {
    u16* X1 = (u16*)(p.ws + W_S1);
    f32x4 x[NB][4];
#pragma unroll
    for (int b = 0; b < NB; ++b) { const u16* xr = X1 + (size_t)(rowb + b * rstride) * DM;
#pragma unroll
        for (int i = 0; i < 4; ++i) { const u32x2 xw = __builtin_nontemporal_load((const u32x2*)(xr + i * 256 + lane * 4)); x[b][i] = (f32x4){bflo(xw.x), bfhi(xw.x), bflo(xw.y), bfhi(xw.y)}; } }
    if (FIRST && NB == 1 && rowb >= ROW_S) {
        const float* pr = (const float*)(p.ws + W_S2) + (size_t)(rowb - ROW_S) * DM;
#pragma unroll
        for (int i = 0; i < 4; ++i) x[0][i] += *(const f32x4*)(pr + i * 256 + lane * 4);
    }
    if (!FIRST && NB == 1 && rowb >= ROW_S) {
        f32x4 pp[8][4];
#pragma unroll
        for (int sl = 0; sl < 8; ++sl) { const float* pr = part_row(p.ws, sl, rowb - ROW_S);
#pragma unroll
            for (int i = 0; i < 4; ++i) pp[sl][i] = *(const f32x4*)(pr + i * 256 + lane * 4); }
#pragma unroll
        for (int i = 0; i < 4; ++i) { f32x4 a = x[0][i] * ALPHA;
#pragma unroll
            for (int sl = 0; sl < 8; ++sl) a += pp[sl][i];
            x[0][i] = a; }
    }
#pragma unroll
    for (int b = 0; b < NB; ++b) {
        float* yr = yrow(p, rowb + b * rstride); const int row = rowb + b * rstride;
        float s = 0.f;
#pragma unroll
        for (int i = 0; i < 4; ++i) s += (x[b][i][0] + x[b][i][1]) + (x[b][i][2] + x[b][i][3]);
#pragma unroll
        for (int o = 1; o < 64; o <<= 1) s += __shfl_xor(s, o);
        const float mu = s * (1.0f / 1024.0f); float q = 0.f;
#pragma unroll
        for (int i = 0; i < 4; ++i) { const f32x4 d = x[b][i] - mu; q += (d[0] * d[0] + d[1] * d[1]) + (d[2] * d[2] + d[3] * d[3]); }
#pragma unroll
        for (int o = 1; o < 64; o <<= 1) q += __shfl_xor(q, o);
        const float rstd = rsqrtf(q * (1.0f / 1024.0f) + 1e-5f);
#pragma unroll
        for (int i = 0; i < 4; ++i) { const int c = i * 256 + lane * 4; const f32x4 gg = *(const f32x4*)(gam + c), bb = *(const f32x4*)(bet + c);
            const f32x4 y = (x[b][i] - mu) * rstd * gg + bb; if (!FIRST) __builtin_nontemporal_store(y, (f32x4*)(yr + c));
            if (FIRST) { u32x2 w; w.x = cvt_pk_bf16(y[0], y[1]); w.y = cvt_pk_bf16(y[2], y[3]); *(u32x2*)(X1 + (size_t)row * DM + c) = w; } }
    }
}
template <bool FIRST>
__device__ __forceinline__ void ln_phase(const Params& p, int bid, int wv, int lane, int G) {
    const float* gam = p.in[FIRST ? 14 : 20]; const float* bet = p.in[FIRST ? 15 : 21];
    const int r0 = bid * 8 + wv, st = G * 8;
    int i = 0;
    for (; r0 + st * (i + 3) < ROW_S; i += 4) ln_rows<FIRST, 4>(p, r0 + st * i, st, lane, gam, bet);
    for (; r0 + st * i < (FIRST ? MROWS : ROW_M); ++i) ln_rows<FIRST, 1>(p, r0 + st * i, st, lane, gam, bet);
}

#define XB_TMO      128
#define XB_XCNT(j)  (256  + 64 * (j))
#define XB_XSUB(j)  (1280 + 64 * (j))
#define XB_XGEN(j)  (2304 + 64 * (j))
#define XB_TOP      3328
#define XB_TOPGEN   3392
#define XCD_BAR_WORDS 3456
#define XB_SPIN_CAP (1u << 18)
static_assert(2 * XCD_BAR_WORDS * 4 <= CTL_BYTES, "barrier words");
__device__ __forceinline__ unsigned xb_ld(unsigned* p)              { return __hip_atomic_load(p, __ATOMIC_RELAXED, __HIP_MEMORY_SCOPE_AGENT); }
__device__ __forceinline__ unsigned xb_add(unsigned* p, unsigned v) { return __hip_atomic_fetch_add(p, v, __ATOMIC_RELAXED, __HIP_MEMORY_SCOPE_AGENT); }
__device__ __forceinline__ unsigned xb_xcc_id() { return (unsigned)__builtin_amdgcn_s_getreg((3 << 11) | 20) & 0xFu; }
#define XB_SPIN(cond, bar) do { unsigned _sp = 0; while (cond) { __builtin_amdgcn_s_sleep(1); \
    if ((++_sp & 255u) == 0u) { if (xb_ld(&(bar)[XB_TMO])) break; if (_sp > XB_SPIN_CAP) { atomicAdd(&(bar)[XB_TMO], 1u); break; } } } } while (0)
struct XcdBarrier { unsigned* bar; unsigned x; volatile LAS unsigned* st; };
__device__ __forceinline__ XcdBarrier xcd_barrier_post(unsigned* bar, volatile LAS unsigned* st) {
    XcdBarrier b; b.bar = bar; b.x = xb_xcc_id(); b.st = st;
    if (threadIdx.x == 0) (void)xb_add(&bar[XB_XCNT(b.x)], 1u);
    return b;
}
__device__ __forceinline__ void xcd_barrier_complete(unsigned* bar, unsigned x, unsigned& nloc, unsigned& nx) {
    const unsigned G = gridDim.x * gridDim.y * gridDim.z;
    unsigned sum, cnt, mine, sp = 0u;
    for (;;) {
        sum = 0u; cnt = 0u; mine = 0u;
#pragma unroll
        for (unsigned j = 0; j < 16; ++j) { const unsigned c = xb_ld(&bar[XB_XCNT(j)]); sum += c; cnt += (c > 0u) ? 1u : 0u; mine = (j == x) ? c : mine; }
        if (sum == G) break;
        __builtin_amdgcn_s_sleep(1);
        if ((++sp & 255u) == 0u) { if (xb_ld(&bar[XB_TMO])) break; if (sp > XB_SPIN_CAP) { atomicAdd(&bar[XB_TMO], 1u); break; } }
    }
    nloc = mine > 0u ? mine : 1u; nx = cnt > 0u ? cnt : 1u;
}
__device__ __forceinline__ void xcd_barrier(const XcdBarrier& b) {
    asm volatile("s_waitcnt vmcnt(0)" ::: "memory");
    __syncthreads();
    if (threadIdx.x == 0) {
        unsigned* bar = b.bar;
        __builtin_amdgcn_s_waitcnt(0);
        unsigned nloc = b.st[0], nx = b.st[1];
        if (nloc == 0u) { xcd_barrier_complete(bar, b.x, nloc, nx); b.st[0] = nloc; b.st[1] = nx; }
        const unsigned old = xb_add(&bar[XB_XSUB(b.x)], 1u);
        const unsigned gen = old / nloc;
        if (old + 1u == (gen + 1u) * nloc) {
            __builtin_amdgcn_fence(__ATOMIC_RELEASE, "agent");
            asm volatile("s_waitcnt vmcnt(0)" ::: "memory");
            const unsigned og = xb_add(&bar[XB_TOP], 1u);
            const unsigned tg = og / nx;
            if (og + 1u == (tg + 1u) * nx) xb_add(&bar[XB_TOPGEN], 1u);
            else XB_SPIN(xb_ld(&bar[XB_TOPGEN]) == tg, bar);
            __builtin_amdgcn_fence(__ATOMIC_ACQUIRE, "agent");
            xb_add(&bar[XB_XGEN(b.x)], 1u);
            asm volatile("s_waitcnt vmcnt(0)" ::: "memory");
        } else {
            XB_SPIN(xb_ld(&bar[XB_XGEN(b.x)]) == gen, bar);
            __builtin_amdgcn_fence(__ATOMIC_ACQUIRE, "agent");
            asm volatile("s_waitcnt vmcnt(0)" ::: "memory");
        }
    }
    __syncthreads();
}

__global__ void __launch_bounds__(512, 2) fwd_megakernel(Params p) {
    extern __shared__ __attribute__((aligned(16))) unsigned char lds_raw[];
    LAS unsigned char* lds = (LAS unsigned char*)lds_raw;
    cg::grid_group grid = cg::this_grid();
    const int tid = threadIdx.x, lane = tid & 63, wv = tid >> 6, G = gridDim.x, bid = blockIdx.x;
    const size_t gtid = (size_t)bid * 512 + tid, gthreads = (size_t)G * 512;
    volatile LAS unsigned* bst = (volatile LAS unsigned*)(lds + LDS_BYTES - 16);
    if (tid == 0) { bst[0] = 0u; bst[1] = 0u; }
    __syncthreads();
    const XcdBarrier gbar = xcd_barrier_post((unsigned*)(p.ws + W_CTL) + p.bli * XCD_BAR_WORDS, bst);
    if (p.ph_lo < 0) grid.sync();

#define IN(k) (p.ph_lo <= (k) && (k) < p.ph_hi)
#define SEAM(k) do { if (IN(k) && IN((k) + 1)) xcd_barrier(gbar); } while (0)
    {
        if (IN(0)) {
            for (int t0 = bid; t0 < 1920 + 256; t0 += 4 * G) {
                TDesc d[4];
#pragma unroll
                for (int q = 0; q < 4; ++q) { const int t = t0 + q * G; d[q].valid = t < 1920 + 256; d[q].perm = false; d[q].K = DM;
                    if (t < 1920) { d[q].W = p.in[9]; d[q].Wt = (u16*)(p.ws + W_WIN); d[q].N = INC; d[q].tile = t; }
                    else { d[q].W = p.in[13]; d[q].Wt = (u16*)(p.ws + W_WOUT); d[q].N = DM; d[q].tile = t - 1920; } }
                transpose4(d, (LAS float*)lds);
            }
            u16* Xb = (u16*)((unsigned char*)p.out + OB_XB);
            for (size_t it = gtid; it < (size_t)MROWS * 128; it += gthreads) { const int row = (int)(it >> 7), cgp = (int)(it & 127);
                const float* s = xrow(p, row) + cgp * 8; const f32x4 a = __builtin_nontemporal_load((const f32x4*)s), b = __builtin_nontemporal_load((const f32x4*)(s + 4));
                u32x4 w; w.x = cvt_pk_bf16(a[0], a[1]); w.y = cvt_pk_bf16(a[2], a[3]); w.z = cvt_pk_bf16(b[0], b[1]); w.w = cvt_pk_bf16(b[2], b[3]);
                *(u32x4*)(Xb + (size_t)row * DM + cgp * 8) = w; }
            if (bid == 0) for (int c = tid; c < 1024; c += 512) { const float a0 = p.in[11][c], a1 = p.in[11][1024 + c], mm = fmaxf(a0, a1), e0 = __expf(a0 - mm), e1 = __expf(a1 - mm);
                ((float*)(p.ws + W_LB))[c] = e0 / (e0 + e1); }
}
        SEAM(0);
        if (IN(1)) {
            pg8::Gemm g{(const u16*)((unsigned char*)p.out + OB_XB), (const u16*)(p.ws + W_WIN), MPAD, INC, DM, DM, DM};
            pg8::StaticOrder S; S.init(ROW_M, INC, DM, G, bid);
            EpiIn E{p};
            pg8::gemm_phase<EpiIn, pg8::StaticOrder>(lds, g, S, E);
            meta_inproj(p, bid, __builtin_amdgcn_readfirstlane(wv), lane, G);
        }
        SEAM(1);
        if (IN(2)) {
            for (int it = bid; it < 256; it += G) hgrn_prompt_item<false>(p, lds, it >> 3, it & 7);
            attn_prompt_items(p, lds, bid, G);
            attn_sample_items(p, lds, bid, G);
            for (int it = bid; it < 1024; it += G) hgrn_sample_item(p, lds, it >> 3, it & 7);
        }
        SEAM(2);
        if (IN(3)) {
            float* Lb = (float*)(p.ws + W_L); const float* Dg = (const float*)(p.ws + W_DG);
            for (int e = bid * 512 + tid; e < 131072; e += G * 512) {
                const int hh = e >> 14, itq = (e >> 8) & 7, ln = (e >> 2) & 63, jj = e & 3, dk = itq * 16 + (ln >> 4) * 4 + jj;
                float Sx = 0.f;
#pragma unroll 8
                for (int gg = 0; gg < 32; ++gg) { const float l = Lb[(size_t)gg * 131072 + e], d = Dg[(gg * 8 + hh) * 128 + dk]; Lb[(size_t)gg * 131072 + e] = Sx; Sx = d * Sx + l; }
            }
            xcd_barrier(gbar);
        }
        if (IN(3)) {
            for (int it = bid; it < 256; it += G) hgrn_prompt_item<true>(p, lds, it >> 3, it & 7);
        }
        SEAM(3);
        if (IN(4)) {
            const u16* OH = (const u16*)(p.ws + W_S1); u16* HG = (u16*)(p.ws + W_S4); const u16* GA = (const u16*)(p.ws + W_S5); const u16* GB = (const u16*)(p.ws + W_S6);
            const u16* OA = (const u16*)((const unsigned char*)p.out + OB_Q); const float* ng = p.in[12];
            for (int row0 = bid * 8 + wv; row0 < MROWS; row0 += G * 16) {
                u32x4 oh[2][2], hgv[2][2], gav[2][2], gbv[2][2], oav[2][2];
#pragma unroll
                for (int rr = 0; rr < 2; ++rr) { const int row = min(row0 + rr * G * 8, MROWS - 1);
#pragma unroll
                    for (int hf = 0; hf < 2; ++hf) { const size_t a = (size_t)row * DM + hf * 512 + lane * 8;
                        oh[rr][hf] = __builtin_nontemporal_load((const u32x4*)(OH + a)); hgv[rr][hf] = __builtin_nontemporal_load((const u32x4*)(HG + a)); gav[rr][hf] = __builtin_nontemporal_load((const u32x4*)(GA + a)); gbv[rr][hf] = __builtin_nontemporal_load((const u32x4*)(GB + a)); oav[rr][hf] = __builtin_nontemporal_load((const u32x4*)(OA + a)); } }
#pragma unroll
                for (int rr = 0; rr < 2; ++rr) {
                    const int row = row0 + rr * G * 8;
                    float ss = 0.f;
#pragma unroll
                    for (int hf = 0; hf < 2; ++hf)
#pragma unroll
                        for (int j = 0; j < 4; ++j) { const float a = bflo(oh[rr][hf][j]), b = bfhi(oh[rr][hf][j]); ss += a * a + b * b; }
#pragma unroll
                    for (int o = 1; o < 64; o <<= 1) ss += __shfl_xor(ss, o);
                    const float rstd = rsqrtf(ss * (1.0f / 1024.0f) + 1e-6f);
                    if (row < MROWS) {
#pragma unroll
                        for (int hf = 0; hf < 2; ++hf) { const size_t a = (size_t)row * DM + hf * 512 + lane * 8;
                            const u32x4 hg = hgv[rr][hf], ga = gav[rr][hf], gb = gbv[rr][hf], oa = oav[rr][hf];
                            const f32x4 n0 = *(const f32x4*)(ng + hf * 512 + lane * 8), n1 = *(const f32x4*)(ng + hf * 512 + lane * 8 + 4);
                            float v[8];
#pragma unroll
                            for (int j = 0; j < 4; ++j) {
                                const float g0 = (j < 2) ? n0[2 * j] : n1[2 * j - 4], g1 = (j < 2) ? n0[2 * j + 1] : n1[2 * j - 3];
                                const float h0 = bflo(hg[j]), h1 = bfhi(hg[j]);
                                v[2 * j] = sigmoidf_(bflo(ga[j])) * bflo(oa[j]) + sigmoidf_(bflo(gb[j])) * (bflo(oh[rr][hf][j]) * rstd * g0) * (h0 * sigmoidf_(h0));
                                v[2 * j + 1] = sigmoidf_(bfhi(ga[j])) * bfhi(oa[j]) + sigmoidf_(bfhi(gb[j])) * (bfhi(oh[rr][hf][j]) * rstd * g1) * (h1 * sigmoidf_(h1));
                            }
                            *(u32x4*)(HG + a) = pack8(v); }
                    }
                }
            }
        }
        SEAM(4);
        if (IN(5)) {
            pg8::Gemm g{(const u16*)(p.ws + W_S4), (const u16*)(p.ws + W_WOUT), MPAD, DM, DM, DM, DM};
            pg8::TailOrder S; S.init(DM, G, bid);
            EpiRes1 E{p};
            pg8::gemm_phase<EpiRes1, pg8::TailOrder>(lds, g, S, E);
            if (bid >= 40) {
                for (int t0 = bid - 40; t0 < 1408 + 704; t0 += 4 * (G - 40)) {
                    TDesc d[4];
#pragma unroll
                    for (int q = 0; q < 4; ++q) { const int t = t0 + q * (G - 40); d[q].valid = t < 1408 + 704;
                        if (t < 1408) { d[q].W = p.in[16]; d[q].Wt = (u16*)(p.ws + W_WUP); d[q].K = DM; d[q].N = UVW; d[q].tile = t; d[q].perm = true; }
                        else { d[q].W = p.in[19]; d[q].Wt = (u16*)(p.ws + W_WDN); d[q].K = DFF; d[q].N = DM; d[q].tile = t - 1408; d[q].perm = false; } }
                    transpose4(d, (LAS float*)lds);
                }
                for (size_t it = (size_t)(bid - 40) * 512 + tid; it < (size_t)2 * NBATCH * 120 * 64; it += (size_t)(G - 40) * 512) { const int sel = (int)(it / ((size_t)NBATCH * 120 * 64)); const size_t r = it % ((size_t)NBATCH * 120 * 64);
                    const int b = (int)(r / (120 * 64)), q = (int)(r % (120 * 64));
                    const f32x4 v = __builtin_nontemporal_load((const f32x4*)(p.in[4 + sel] + ((size_t)b * 128 + 8) * 256 + (size_t)q * 4));
                    __builtin_nontemporal_store(v, (f32x4*)(p.out + (sel ? O_WINVS : O_WINKS) + (size_t)b * 128 * 256 + (size_t)q * 4)); }
                    }
        }
        SEAM(5);
        if (IN(6)) {
            ln_phase<true>(p, bid, wv, lane, G);
        }
        SEAM(6);
        if (IN(7)) {
            pg8::Gemm g{(const u16*)(p.ws + W_S1), (const u16*)(p.ws + W_WUP), MPAD, UVW, DM, DM, DM};
            pg8::StaticOrder S; S.init(MPAD, UVW, DM, G, bid);
            EpiUp E{p, (LAS float*)(lds + 131072)};
            pg8::gemm_phase<EpiUp, pg8::StaticOrder>(lds, g, S, E);
        }
        SEAM(7);
        if (IN(9)) {
            pg8::Gemm g{(const u16*)(p.ws + W_UV) + DFF, (const u16*)(p.ws + W_WDN), MPAD, DM, DFF, UVW, DFF};
            pg8::SplitOrder S; S.init(DFF, G, bid);
            {
                pg8::Unit u0;
                if (S.next(0, u0)) {
                    u16* UV = (u16*)(p.ws + W_UV); const float* cw = p.in[17]; const float* cb = p.in[18];
                    const u16* HA = (const u16*)(p.ws + W_HALO) + (size_t)(u0.pm == 0 ? 69 : u0.pm - 1) * 2 * DFF;
                    const u16* FU = (const u16*)(p.ws + W_FIXU) + (size_t)u0.pm * 2 * DFF; const u16* FV = (const u16*)(p.ws + W_FIXV) + (size_t)u0.pm * 2 * DFF;
                    for (int idx = tid; idx < 2 * 352; idx += 512) {
                        const int r = idx / 352, c = (idx % 352) * 8;
                        const u32x4 h0 = *(const u32x4*)(HA + c), h1 = *(const u32x4*)(HA + DFF + c), f0 = *(const u32x4*)(FU + c), f1 = *(const u32x4*)(FU + DFF + c), fv = *(const u32x4*)(FV + (size_t)r * DFF + c);
                        const u32x4 a2 = r == 0 ? h0 : h1, a1 = r == 0 ? h1 : f0, a0 = r == 0 ? f0 : f1;
                        const f32x4 w0a = *(const f32x4*)(cw + c), w0b = *(const f32x4*)(cw + c + 4), w1a = *(const f32x4*)(cw + DFF + c), w1b = *(const f32x4*)(cw + DFF + c + 4),
                                    w2a = *(const f32x4*)(cw + 2 * DFF + c), w2b = *(const f32x4*)(cw + 2 * DFF + c + 4), ba = *(const f32x4*)(cb + c), bb = *(const f32x4*)(cb + c + 4);
                        float hv[8];
#pragma unroll
                        for (int e = 0; e < 8; ++e) {
                            const float x2 = (e & 1) ? bfhi(a2[e >> 1]) : bflo(a2[e >> 1]), x1 = (e & 1) ? bfhi(a1[e >> 1]) : bflo(a1[e >> 1]), x0 = (e & 1) ? bfhi(a0[e >> 1]) : bflo(a0[e >> 1]);
                            const float vl = (e & 1) ? bfhi(fv[e >> 1]) : bflo(fv[e >> 1]);
                            const float w0 = e < 4 ? w0a[e & 3] : w0b[e & 3], w1 = e < 4 ? w1a[e & 3] : w1b[e & 3], w2 = e < 4 ? w2a[e & 3] : w2b[e & 3], b0 = e < 4 ? ba[e & 3] : bb[e & 3];
                            hv[e] = gelu_tanh_f(b0 + w0 * x2 + w1 * x1 + w2 * x0) * vl;
                        }
                        *(u32x4*)(UV + (size_t)(u0.pm * 256 + r) * UVW + DFF + c) = pack8(hv);
                    }
                    __threadfence();
                    __syncthreads();
                }
            }
            EpiRes2 E{p};
            pg8::gemm_phase<EpiRes2, pg8::SplitOrder>(lds, g, S, E);
        }
        SEAM(9);
        if (IN(10)) ln_phase<false>(p, bid, wv, lane, G);
    }
}

constexpr int N_PHASES = 11;
#ifndef PH_HI
#define PH_HI N_PHASES
#endif

extern "C" void kernel_launch(void* const* d_in, const int* in_sizes, int n_in, void* d_out, int out_size, void* d_ws, size_t ws_size, hipStream_t stream) {
    static int grid_blocks = 0;
    if (!grid_blocks) {
        if (n_in != 22 || ws_size < WS_NEED || out_size != 43922944) { fprintf(stderr, "kernel_launch: unexpected problem (n_in %d, ws %zu, out %d)\n", n_in, ws_size, out_size); grid_blocks = -1; return; }
        int dev = 0, cus = 0, per_cu = 0;
        hipGetDevice(&dev);
        hipDeviceGetAttribute(&cus, hipDeviceAttributeMultiprocessorCount, dev);
        hipFuncSetAttribute((const void*)fwd_megakernel, hipFuncAttributeMaxDynamicSharedMemorySize, LDS_BYTES);
        hipOccupancyMaxActiveBlocksPerMultiprocessor(&per_cu, (const void*)fwd_megakernel, 512, LDS_BYTES);
        if (per_cu < 1) { fprintf(stderr, "kernel_launch: occupancy query says %d blocks per CU\n", per_cu); per_cu = 1; }
        grid_blocks = cus;
    }
    if (grid_blocks < 0) return;
    Params p{};
    for (int i = 0; i < 22; ++i) p.in[i] = (const float*)d_in[i];
    p.out = (float*)d_out; p.ws = (unsigned char*)d_ws;
    (void)hipMemsetAsync((unsigned char*)d_ws + W_CTL, 0, CTL_BYTES, stream);
#ifdef PREFIX_K
    { Params q = p; q.ph_lo = 0; q.ph_hi = PREFIX_K; q.bli = 1; void* a2[] = {&q};
      hipLaunchCooperativeKernel((const void*)fwd_megakernel, dim3(grid_blocks), dim3(512), a2, LDS_BYTES, stream); }
#endif
    p.ph_lo = 0; p.ph_hi = PH_HI;
    void* args[] = {&p};
    hipError_t e = hipLaunchCooperativeKernel((const void*)fwd_megakernel, dim3(grid_blocks), dim3(512), args, LDS_BYTES, stream);
    if (e != hipSuccess) fprintf(stderr, "cooperative launch failed: %s (grid %d)\n", hipGetErrorString(e), grid_blocks);
}
```

```cpp
#include <hip/hip_runtime.h>
#include <hip/hip_cooperative_groups.h>
#include <cstdio>
#include <cstdint>
namespace cg = cooperative_groups;

#define LAS __attribute__((address_space(3)))
typedef unsigned short u16;
typedef short bf16x8 __attribute__((ext_vector_type(8)));
typedef float f32x4 __attribute__((ext_vector_type(4)));
typedef unsigned u32x4 __attribute__((ext_vector_type(4)));
typedef unsigned u32x2 __attribute__((ext_vector_type(2)));

constexpr int DM = 1024, NPR = 16384, NSM = 1024, NMETA = 16;
constexpr int ROW_S = 16384, ROW_M = 17408, MROWS = 17424, MPAD = 17664;
constexpr int INC = 7680, DFF = 2816, UVW = 5632;
constexpr int NBATCH = 128, NTOK = 8;
constexpr float ALPHA = 1.189207115002721f;
constexpr size_t O_Y = 0, O_METAK = 17825792, O_METAV = 17829888, O_WINKP = 17833984, O_WINVP = 17866752, O_HGP = 17899520,
                 O_CONVP = 18030592, O_WINKS = 18036224, O_WINVS = 22230528, O_HGS = 26424832, O_CONVS = 43202048;
constexpr size_t OB_Q = 0;
constexpr size_t OB_KV = (size_t)MROWS * 2048;
constexpr size_t OB_XB = O_HGS * 4;
constexpr size_t SLOT = (size_t)MROWS * 2048;
constexpr size_t W_WIN = 0, W_WUP = 0, W_WDN = (size_t)UVW * DM * 2;
constexpr size_t W_S1 = 17825792, W_S2 = W_S1 + SLOT, W_S3 = W_S2 + SLOT, W_S4 = W_S3 + SLOT, W_S5 = W_S4 + SLOT, W_S6 = W_S5 + SLOT;
constexpr size_t W_L = W_S6 + SLOT;
constexpr size_t W_UV = W_S2;
constexpr size_t W_SMALL = (size_t)250 * 1024 * 1024;
constexpr size_t W_WOUT = W_SMALL + (size_t)2 * 1024 * 1024;
constexpr size_t W_CTL = W_SMALL + (size_t)1280 * 1024;
constexpr size_t CTL_BYTES = 32768;
constexpr size_t W_HALO = W_SMALL + (size_t)4 * 1024 * 1024;
constexpr size_t W_FIXU = W_HALO + (size_t)70 * 2 * DFF * 2;
constexpr size_t W_FIXV = W_SMALL + 4096 + 131072 + 65536;
static_assert(W_FIXU + (size_t)64 * 2 * DFF * 2 <= (size_t)256 * 1024 * 1024 && W_FIXV + (size_t)64 * 2 * DFF * 2 <= W_CTL, "halo buffers");
__device__ __forceinline__ float* part_row(unsigned char* ws, int sl, int r) { return (float*)(ws + W_UV + ((size_t)sl * 1024 + r) * ((size_t)UVW * 2)); }
constexpr size_t W_LB = W_SMALL, W_DG = W_SMALL + 4096, W_YT = W_SMALL + 4096 + 131072;
constexpr size_t WS_NEED = (size_t)256 * 1024 * 1024;
static_assert(W_L + 16777216 <= W_SMALL && W_UV + (size_t)MPAD * UVW * 2 <= W_SMALL && W_YT + 1048576 <= WS_NEED, "ws layout");
static_assert(W_WOUT + 2097152 <= WS_NEED && W_WDN + (size_t)DM * DFF * 2 <= W_S1 && (size_t)INC * DM * 2 <= W_S1, "ws layout");
constexpr int LDS_BYTES = 155648;

struct Params { const float* in[22]; float* out; unsigned char* ws; int ph_lo, ph_hi, bli, pad; };

typedef __bf16 bf16x2_t __attribute__((ext_vector_type(2)));
typedef float f32x2_t __attribute__((ext_vector_type(2)));
__device__ __forceinline__ unsigned cvt_pk_bf16(float lo, float hi) { bf16x2_t r = __builtin_convertvector((f32x2_t){lo, hi}, bf16x2_t); return __builtin_bit_cast(unsigned, r); }
__device__ __forceinline__ float bf2f(u16 v) { return __uint_as_float((unsigned)v << 16); }
__device__ __forceinline__ float bflo(unsigned w) { return __uint_as_float(w << 16); }
__device__ __forceinline__ float bfhi(unsigned w) { return __uint_as_float(w & 0xffff0000u); }
__device__ __forceinline__ u16 f2bf(float f) { return (u16)(cvt_pk_bf16(f, 0.f) & 0xffffu); }
__device__ __forceinline__ float h2f(u16 v) { return (float)__builtin_bit_cast(_Float16, v); }
__device__ __forceinline__ u16 f2h(float f) { return __builtin_bit_cast(u16, (_Float16)f); }
__device__ __forceinline__ float sigmoidf_(float x) { return __builtin_amdgcn_rcpf(1.0f + __expf(-x)); }
__device__ __forceinline__ u32x4 pack8(const float* v) { u32x4 w; w.x = cvt_pk_bf16(v[0], v[1]); w.y = cvt_pk_bf16(v[2], v[3]); w.z = cvt_pk_bf16(v[4], v[5]); w.w = cvt_pk_bf16(v[6], v[7]); return w; }
__device__ __forceinline__ const float* xrow(const Params& p, int row) {
    return row < ROW_S ? p.in[0] + (size_t)row * DM : (row < ROW_M ? p.in[1] + (size_t)(row - ROW_S) * DM : p.in[8] + (size_t)(row - ROW_M) * DM);
}
__device__ __forceinline__ float* yrow(const Params& p, int row) {
    return row < ROW_M ? p.out + (size_t)row * DM : (float*)(p.ws + W_YT) + (size_t)(row - ROW_M) * DM;
}

namespace pg8 {
constexpr int BM = 256, BK = 64, HALF = 128, HTB = HALF * BK * 2, NXCD = 8, WGM = 8;
__device__ __forceinline__ int lds_byte(int r, int c) { const int st = (r >> 4) * 2 + (c >> 5), rr = r & 15, cc = c & 31, ob = rr * 64 + cc * 2; return st * 1024 + (ob ^ (((ob >> 9) & 1) << 5)); }
__device__ __forceinline__ void stage_rc(int b, int& R, int& C) { const int st = b / 1024, sb = b % 1024, swz = sb ^ (((sb >> 9) & 1) << 5); R = (st >> 1) * 16 + swz / 64; C = (st & 1) * 32 + (swz % 64) / 2; }
__device__ __forceinline__ int perm32(int rho) { const int n = rho >> 4, i = rho & 15; return 8 * (i >> 2) + 4 * n + (i & 3); }
struct Unit { int pm, pn, k0, nk, sl; };
struct Gemm { const u16* A; const u16* Bt; int M, N, K, lda, ldb; };
struct StaticOrder {
    int nM, nN, nwg, G, c, nkt;
    __device__ __forceinline__ void init(int M, int N, int K, int G_, int c_) { nM = M / BM; nN = N / BM; nwg = nM * nN; G = G_; c = c_; nkt = K / BK; }
    __device__ __forceinline__ bool next(int i, Unit& u) const {
        const long L = (long)i * G + c; if (L >= nwg) return false;
        int wgid = (int)L; { const int q = nwg / NXCD, r = nwg % NXCD, xcd = wgid % NXCD, off = wgid / NXCD; wgid = (xcd < r ? xcd * (q + 1) : r * (q + 1) + (xcd - r) * q) + off; }
        const int nig = WGM * nN, gid = wgid / nig, fm = gid * WGM, gsz = (nM - fm) < WGM ? (nM - fm) : WGM;
        u.pm = fm + ((wgid % nig) % gsz); u.pn = (wgid % nig) / gsz; u.k0 = 0; u.nk = nkt; u.sl = -1; return true;
    }
};
struct SplitOrder {
    StaticOrder base; int c;
    __device__ __forceinline__ void init(int K, int G_, int c_) { base.init(NPR, DM, K, G_, c_); c = c_; }
    __device__ __forceinline__ bool next(int i, Unit& u) const {
        if (i == 0) return base.next(0, u);
        if (i > 1 || c >= 128) return false;
        const int tile = c >> 3, sl = c & 7;
        u.pm = 64 + (tile >> 2); u.pn = tile & 3; u.sl = sl; u.k0 = sl < 6 ? sl * 6 : 36 + (sl - 6) * 4; u.nk = sl < 6 ? 6 : 4; return true;
    }
};
struct TailOrder {
    StaticOrder base; int c;
    __device__ __forceinline__ void init(int K, int G_, int c_) { base.init(NPR, DM, K, G_, c_); c = c_; }
    __device__ __forceinline__ bool next(int i, Unit& u) const {
        if (i == 0) return base.next(0, u);
        if (i > 1 || c >= 40) return false;
        const int tile = c >> 1, h = c & 1;
        u.pm = 64 + (tile >> 2); u.pn = tile & 3; u.k0 = h * (base.nkt >> 1); u.nk = base.nkt >> 1; u.sl = h; return true;
    }
};
template <class Epi, class Sched>
__device__ __forceinline__ void gemm_phase(LAS unsigned char* lds, const Gemm g, const Sched& S, const Epi& E) {
    const int tid = threadIdx.x, wid = __builtin_amdgcn_readfirstlane(tid >> 6), lane = tid & 63, wr = wid >> 2, wc = wid & 3, fr = lane & 15, fq = lane >> 4;
    unsigned voffA[2], voffB[2];
#pragma unroll
    for (int i = 0; i < 2; ++i) { int R, C; stage_rc(tid * 16 + i * 8192, R, C); const int Rb = (R & ~31) + perm32(R & 31);
        voffA[i] = (unsigned)(R * g.lda + C) * 2u; voffB[i] = (unsigned)(Rb * g.ldb + C) * 2u; }
    const size_t kstep = (size_t)(BK * 2);
    const size_t hstepA = (size_t)HALF * g.lda * 2, hstepB = (size_t)HALF * g.ldb * 2;
    const size_t tstepA = 2 * hstepA, tstepB = 2 * hstepB;
    const unsigned ldsw = (unsigned)wid * 1024u;
    const int aoff = lds_byte(wr * 64 + fr, fq * 8), boff = lds_byte(wc * 32 + fr, fq * 8);
#define PG8_SA(b, h) (((b) * 2 + (h)) * HTB)
#define PG8_SB(b, h) ((4 + (b) * 2 + (h)) * HTB)
#define PG8_STAGE(bufoff, gbase, voff) do { _Pragma("unroll") for (int _i = 0; _i < 2; ++_i) \
        __builtin_amdgcn_global_load_lds((const unsigned*)((const char*)(gbase) + (voff)[_i]), (LAS unsigned*)(lds + (bufoff) + ldsw + _i * 8192), 16, 0, 0); } while (0)
#define PG8_LDA(dst, b, h) do { _Pragma("unroll") for (int m = 0; m < 4; ++m) _Pragma("unroll") for (int k = 0; k < 2; ++k) dst[m][k] = *(const LAS bf16x8*)(lds + PG8_SA(b, h) + aoff + m * 2048 + k * 1024); } while (0)
#define PG8_LDB(dst, b, h) do { _Pragma("unroll") for (int n = 0; n < 2; ++n) _Pragma("unroll") for (int k = 0; k < 2; ++k) dst[n][k] = *(const LAS bf16x8*)(lds + PG8_SB(b, h) + boff + n * 2048 + k * 1024); } while (0)
#define PG8_MMA(ai, bj, At, Bt) do { __builtin_amdgcn_s_setprio(1); _Pragma("unroll") for (int m = 0; m < 4; ++m) _Pragma("unroll") for (int n = 0; n < 2; ++n) _Pragma("unroll") for (int k = 0; k < 2; ++k) \
        acc[ai][bj][m][n] = __builtin_amdgcn_mfma_f32_16x16x32_bf16(Bt[n][k], At[m][k], acc[ai][bj][m][n], 0, 0, 0); __builtin_amdgcn_s_setprio(0); } while (0)
#define PG8_WAIT_V(n) asm volatile("s_waitcnt vmcnt(" #n ")" ::: "memory")
#define PG8_WAIT_L(n) asm volatile("s_waitcnt lgkmcnt(" #n ")" ::: "memory")
#define PG8_BAR __builtin_amdgcn_s_barrier()
#define PG8_SCHED __builtin_amdgcn_sched_barrier(0)
    Unit cur, nxt; int ui = 0;
    if (!S.next(0, cur)) return;
    f32x4 acc[2][2][4][2];
#pragma unroll
    for (int a = 0; a < 2; ++a)
#pragma unroll
        for (int b = 0; b < 2; ++b)
#pragma unroll
            for (int m = 0; m < 4; ++m)
#pragma unroll
                for (int n = 0; n < 2; ++n) acc[a][b][m][n] = (f32x4){0.f, 0.f, 0.f, 0.f};
    bf16x8 At[4][2], B0[2][2], B1[2][2];
    const char* cA = (const char*)g.A + (size_t)cur.pm * tstepA + (size_t)cur.k0 * kstep; const char* cB = (const char*)g.Bt + (size_t)cur.pn * tstepB + (size_t)cur.k0 * kstep;
    PG8_STAGE(PG8_SB(0, 0), cB, voffB); PG8_STAGE(PG8_SB(0, 1), cB + hstepB, voffB); PG8_STAGE(PG8_SA(0, 0), cA, voffA); PG8_STAGE(PG8_SA(0, 1), cA + hstepA, voffA);
    if (wr == 1) PG8_BAR;
    PG8_WAIT_V(2); PG8_BAR;
    PG8_STAGE(PG8_SB(1, 0), cB + kstep, voffB); PG8_STAGE(PG8_SA(1, 0), cA + kstep, voffA); PG8_STAGE(PG8_SB(1, 1), cB + hstepB + kstep, voffB);
    PG8_WAIT_V(6); PG8_BAR;
    for (;;) {
        const bool has_next = S.next(ui + 1, nxt);
        const char* nA = has_next ? (const char*)g.A + (size_t)nxt.pm * tstepA + (size_t)nxt.k0 * kstep : cA; const char* nB = has_next ? (const char*)g.Bt + (size_t)nxt.pn * tstepB + (size_t)nxt.k0 * kstep : cB;
        const int nt = cur.nk;
        for (int t = 0; t < nt; t += 2) {
            const bool last = (t == nt - 2);
            const char* a1 = cA + (size_t)(t + 1) * kstep;
            const char* a2 = last ? nA : cA + (size_t)(t + 2) * kstep; const char* b2 = last ? nB : cB + (size_t)(t + 2) * kstep;
            const char* a3 = a2 + kstep; const char* b3 = b2 + kstep;
            PG8_LDB(B0, 0, 0); PG8_LDB(B1, 0, 1); PG8_SCHED; PG8_LDA(At, 0, 0); PG8_STAGE(PG8_SA(1, 1), a1 + hstepA, voffA);
            PG8_WAIT_V(8); PG8_WAIT_L(0); PG8_BAR; PG8_MMA(0, 0, At, B0); PG8_MMA(0, 1, At, B1); PG8_BAR; PG8_SCHED;
            PG8_LDA(At, 0, 1); PG8_STAGE(PG8_SB(0, 0), b2, voffB); PG8_STAGE(PG8_SB(0, 1), b2 + hstepB, voffB); PG8_STAGE(PG8_SA(0, 0), a2, voffA);
            PG8_WAIT_V(8); PG8_WAIT_L(0); PG8_BAR; PG8_MMA(1, 0, At, B0); PG8_MMA(1, 1, At, B1); PG8_BAR; PG8_SCHED;
            PG8_LDB(B0, 1, 0); PG8_LDB(B1, 1, 1); PG8_SCHED; PG8_LDA(At, 1, 0); PG8_STAGE(PG8_SA(0, 1), a2 + hstepA, voffA);
            PG8_WAIT_V(8); PG8_WAIT_L(0); PG8_BAR; PG8_MMA(0, 0, At, B0); PG8_MMA(0, 1, At, B1); PG8_BAR; PG8_SCHED;
            PG8_LDA(At, 1, 1); PG8_STAGE(PG8_SB(1, 0), b3, voffB); PG8_STAGE(PG8_SB(1, 1), b3 + hstepB, voffB); PG8_STAGE(PG8_SA(1, 0), a3, voffA);
            PG8_WAIT_V(8); PG8_WAIT_L(0); PG8_BAR; PG8_MMA(1, 0, At, B0); PG8_MMA(1, 1, At, B1); PG8_BAR; PG8_SCHED;
        }
        if (wr == 0) PG8_BAR;
        E(acc, cur, wr, wc, fr, fq);
        if (!has_next) break;
#pragma unroll
        for (int a = 0; a < 2; ++a)
#pragma unroll
            for (int b = 0; b < 2; ++b)
#pragma unroll
                for (int m = 0; m < 4; ++m)
#pragma unroll
                    for (int n = 0; n < 2; ++n) acc[a][b][m][n] = (f32x4){0.f, 0.f, 0.f, 0.f};
        cur = nxt; cA = nA; cB = nB; ++ui;
        if (wr == 1) PG8_BAR;
    }
    PG8_WAIT_V(0);
    PG8_BAR;
#undef PG8_SA
#undef PG8_SB
#undef PG8_STAGE
#undef PG8_LDA
#undef PG8_LDB
#undef PG8_MMA
#undef PG8_WAIT_V
#undef PG8_WAIT_L
#undef PG8_BAR
#undef PG8_SCHED
}
}
using pg8::Unit;

struct EpiIn {
    static constexpr bool PERM = true;
    Params p;
    __device__ __forceinline__ void operator()(const f32x4 (&acc)[2][2][4][2], const Unit& u, int wr, int wc, int fr, int fq) const {
        const int pn = u.pn;
        int mode, ld, c0; u16* base;
        if (pn < 4) { mode = 0; base = (u16*)((unsigned char*)p.out + OB_Q); ld = 1024; c0 = pn * 256; }
        else if (pn < 6) { mode = 1; base = (u16*)((unsigned char*)p.out + OB_KV); ld = 512; c0 = (pn - 4) * 256; }
        else { const int g = (pn - 6) >> 2; c0 = ((pn - 6) & 3) * 256; ld = 1024; base = (u16*)(p.ws + W_S1 + (size_t)g * SLOT);
               mode = (g == 1) ? 3 : 4; }
        const float* lb = (const float*)(p.ws + W_LB);
#pragma unroll
        for (int ai = 0; ai < 2; ++ai)
#pragma unroll
            for (int m = 0; m < 4; ++m) {
                const int row = u.pm * 256 + ai * 128 + wr * 64 + m * 16 + fr;
                if (row >= MROWS) continue;
                float* fo = nullptr;
                if (mode == 1) {
                    const size_t sel = (pn == 4) ? 0 : 1;
                    if (row >= ROW_M) fo = p.out + (sel ? O_METAV : O_METAK) + (size_t)(row - ROW_M) * 256;
                    else if (row >= ROW_S) { const int s = row - ROW_S; fo = p.out + (sel ? O_WINVS : O_WINKS) + ((size_t)(s >> 3) * 128 + 120 + (s & 7)) * 256; }
                    else if (row >= NPR - 128) fo = p.out + (sel ? O_WINVP : O_WINKP) + (size_t)(row - (NPR - 128)) * 256;
                }
#pragma unroll
                for (int bj = 0; bj < 2; ++bj) {
                    const int cl = bj * 128 + wc * 32 + 8 * fq;
                    float v[8];
#pragma unroll
                    for (int j = 0; j < 4; ++j) { v[j] = acc[ai][bj][m][0][j]; v[4 + j] = acc[ai][bj][m][1][j]; }
                    if (mode == 0) {
#pragma unroll
                        for (int j = 0; j < 8; ++j) v[j] *= 0.125f;
                    } else if (mode == 1) {
                        if (fo) { *(f32x4*)(fo + cl) = (f32x4){v[0], v[1], v[2], v[3]}; *(f32x4*)(fo + cl + 4) = (f32x4){v[4], v[5], v[6], v[7]}; }
                    } else if (mode == 2) {
#pragma unroll
                        for (int j = 0; j < 8; ++j) v[j] = v[j] * sigmoidf_(v[j]);
                    } else if (mode == 3) {
                        const f32x4 l0 = *(const f32x4*)(lb + c0 + cl), l1 = *(const f32x4*)(lb + c0 + cl + 4);
                        u32x4 w; unsigned hh[8];
#pragma unroll
                        for (int j = 0; j < 8; ++j) { const float l = j < 4 ? l0[j] : l1[j - 4]; const float f = l + (1.0f - l) * sigmoidf_(v[j]); hh[j] = f2h(__logf(f)); }
                        w.x = hh[0] | (hh[1] << 16); w.y = hh[2] | (hh[3] << 16); w.z = hh[4] | (hh[5] << 16); w.w = hh[6] | (hh[7] << 16);
                        *(u32x4*)(base + (size_t)row * ld + c0 + cl) = w;
                        continue;
                    } else if (mode == 5) {
#pragma unroll
                        for (int j = 0; j < 8; ++j) v[j] = sigmoidf_(v[j]);
                    }
                    *(u32x4*)(base + (size_t)row * ld + c0 + cl) = pack8(v);
                }
            }
    }
};
struct EpiRes1 {
    static constexpr bool PERM = true;
    Params p;
    __device__ __forceinline__ void operator()(const f32x4 (&acc)[2][2][4][2], const Unit& u, int wr, int wc, int fr, int fq) const {
#pragma unroll
        for (int ai = 0; ai < 2; ++ai)
#pragma unroll
            for (int m = 0; m < 4; ++m) {
                const int row = u.pm * 256 + ai * 128 + wr * 64 + m * 16 + fr;
                if (row >= MROWS) continue;
                if (u.sl == 1) {
                    float* pr = (float*)(p.ws + W_S2) + (size_t)(row - ROW_S) * DM;
#pragma unroll
                    for (int bj = 0; bj < 2; ++bj) { const int c = u.pn * 256 + bj * 128 + wc * 32 + 8 * fq;
                        *(f32x4*)(pr + c) = acc[ai][bj][m][0]; *(f32x4*)(pr + c + 4) = acc[ai][bj][m][1]; }
                    continue;
                }
                const float* xr = xrow(p, row); u16* yr = (u16*)(p.ws + W_S1) + (size_t)row * DM;
#pragma unroll
                for (int bj = 0; bj < 2; ++bj) {
                    const int c = u.pn * 256 + bj * 128 + wc * 32 + 8 * fq;
                    const f32x4 x0 = __builtin_nontemporal_load((const f32x4*)(xr + c)), x1 = __builtin_nontemporal_load((const f32x4*)(xr + c + 4));
                    const f32x4 y0 = x0 * ALPHA + acc[ai][bj][m][0], y1 = x1 * ALPHA + acc[ai][bj][m][1];
                    u32x4 w; w.x = cvt_pk_bf16(y0[0], y0[1]); w.y = cvt_pk_bf16(y0[2], y0[3]); w.z = cvt_pk_bf16(y1[0], y1[1]); w.w = cvt_pk_bf16(y1[2], y1[3]);
                    *(u32x4*)(yr + c) = w;
                }
            }
    }
};
struct EpiRes2 {
    static constexpr bool PERM = true;
    Params p;
    __device__ __forceinline__ void operator()(const f32x4 (&acc)[2][2][4][2], const Unit& u, int wr, int wc, int fr, int fq) const {
#pragma unroll
        for (int ai = 0; ai < 2; ++ai)
#pragma unroll
            for (int m = 0; m < 4; ++m) {
                const int row = u.pm * 256 + ai * 128 + wr * 64 + m * 16 + fr;
                if (u.sl >= 0) {
                    float* pr = part_row(p.ws, u.sl, row - ROW_S);
#pragma unroll
                    for (int bj = 0; bj < 2; ++bj) { const int c = u.pn * 256 + bj * 128 + wc * 32 + 8 * fq;
                        *(f32x4*)(pr + c) = acc[ai][bj][m][0]; *(f32x4*)(pr + c + 4) = acc[ai][bj][m][1]; }
                    continue;
                }
                u16* xr = (u16*)(p.ws + W_S1) + (size_t)row * DM;
#pragma unroll
                for (int bj = 0; bj < 2; ++bj) {
                    const int c = u.pn * 256 + bj * 128 + wc * 32 + 8 * fq;
                    const u32x4 xw = *(const u32x4*)(xr + c);
                    const f32x4 x0 = {bflo(xw.x), bfhi(xw.x), bflo(xw.y), bfhi(xw.y)}, x1 = {bflo(xw.z), bfhi(xw.z), bflo(xw.w), bfhi(xw.w)};
                    const f32x4 y0 = x0 * ALPHA + acc[ai][bj][m][0], y1 = x1 * ALPHA + acc[ai][bj][m][1];
                    u32x4 w; w.x = cvt_pk_bf16(y0[0], y0[1]); w.y = cvt_pk_bf16(y0[2], y0[3]); w.z = cvt_pk_bf16(y1[0], y1[1]); w.w = cvt_pk_bf16(y1[2], y1[3]);
                    *(u32x4*)(xr + c) = w;
                }
            }
    }
};
__device__ __forceinline__ float dpp_f(float oldv, float src, const int ctrl_sel) {
    const int o = __builtin_bit_cast(int, oldv), sv = __builtin_bit_cast(int, src); int r;
    if (ctrl_sel == 0) r = __builtin_amdgcn_update_dpp(o, sv, 0x121, 0xF, 0xF, false);
    else if (ctrl_sel == 1) r = __builtin_amdgcn_update_dpp(o, sv, 0x122, 0xF, 0xF, false);
    else if (ctrl_sel == 2) r = __builtin_amdgcn_update_dpp(o, sv, 0x111, 0xF, 0xF, false);
    else r = __builtin_amdgcn_update_dpp(o, sv, 0x112, 0xF, 0xF, false);
    return __builtin_bit_cast(float, r);
}
__device__ __forceinline__ float gelu_tanh_f(float x) {
    const float z = 0.7978845608028654f * (x + 0.044715f * x * x * x);
    const float th = 1.0f - 2.0f * __builtin_amdgcn_rcpf(1.0f + __expf(2.0f * z));
    return 0.5f * x * (1.0f + th);
}
struct EpiUp {
    static constexpr bool PERM = true;
    Params p; LAS float* xch;
    __device__ __forceinline__ void operator()(const f32x4 (&acc)[2][2][4][2], const Unit& u, int wr, int wc, int fr, int fq) const {
        u16* UV = (u16*)(p.ws + W_UV);
        const float* cw = p.in[17]; const float* cb = p.in[18]; const float* sc = p.in[7];
        const int ch0 = u.pn * 128 + wc * 32 + 8 * fq;
        if (fr >= 14) {
#pragma unroll
            for (int ai = 0; ai < 2; ++ai) { LAS float* d = xch + ((((ai * 2 + wr) * 4 + wc) * 2 + (fr & 1)) * 4 + fq) * 8;
                *(LAS f32x4*)d = acc[ai][0][3][0]; *(LAS f32x4*)(d + 4) = acc[ai][0][3][1]; }
        }
        asm volatile("s_waitcnt lgkmcnt(0)" ::: "memory");
        __builtin_amdgcn_s_barrier();
        const bool sample_tile = (u.pm >= 64 && u.pm < 68);
#pragma unroll
        for (int ai = 0; ai < 2; ++ai) {
            f32x4 pv0 = {0.f, 0.f, 0.f, 0.f}, pv1 = pv0;
            if (wr == 1 || ai == 1) { const int pa = (wr == 1) ? ai : 0, pw = (wr == 1) ? 0 : 1;
                LAS const float* d = xch + ((((pa * 2 + pw) * 4 + wc) * 2 + (fr & 1)) * 4 + fq) * 8; pv0 = *(LAS const f32x4*)d; pv1 = *(LAS const f32x4*)(d + 4); }
#pragma unroll
            for (int m = 0; m < 4; ++m) {
                const int row = u.pm * 256 + ai * 128 + wr * 64 + m * 16 + fr;
                float uu[8], vv[8], pp[8], u1[8], u2[8];
#pragma unroll
                for (int j = 0; j < 4; ++j) { uu[j] = acc[ai][0][m][0][j]; uu[4 + j] = acc[ai][0][m][1][j]; vv[j] = acc[ai][1][m][0][j]; vv[4 + j] = acc[ai][1][m][1][j];
                    pp[j] = (m == 0) ? pv0[j] : acc[ai][0][m > 0 ? m - 1 : 0][0][j]; pp[4 + j] = (m == 0) ? pv1[j] : acc[ai][0][m > 0 ? m - 1 : 0][1][j]; }
#pragma unroll
                for (int e = 0; e < 8; ++e) { u1[e] = dpp_f(dpp_f(0.f, pp[e], 0), uu[e], 2); u2[e] = dpp_f(dpp_f(0.f, pp[e], 1), uu[e], 3); }
                if (sample_tile) {
                    const int j8 = fr & 7, b = (row - ROW_S) >> 3;
                    if (j8 < 2) { const float* s1 = sc + ((size_t)b * 2 + 1) * DFF + ch0; const f32x4 a = *(const f32x4*)s1, c4 = *(const f32x4*)(s1 + 4);
                        if (j8 == 0) { const float* s0 = sc + ((size_t)b * 2) * DFF + ch0; const f32x4 a0 = *(const f32x4*)s0, c0 = *(const f32x4*)(s0 + 4);
#pragma unroll
                            for (int j = 0; j < 4; ++j) { u1[j] = a[j]; u1[4 + j] = c4[j]; u2[j] = a0[j]; u2[4 + j] = c0[j]; } }
                        else {
#pragma unroll
                            for (int j = 0; j < 4; ++j) { u2[j] = a[j]; u2[4 + j] = c4[j]; } } }
                }
                if (row < MROWS) {
                    const f32x4 w0a = *(const f32x4*)(cw + ch0), w0b = *(const f32x4*)(cw + ch0 + 4), w1a = *(const f32x4*)(cw + DFF + ch0), w1b = *(const f32x4*)(cw + DFF + ch0 + 4),
                                w2a = *(const f32x4*)(cw + 2 * DFF + ch0), w2b = *(const f32x4*)(cw + 2 * DFF + ch0 + 4), ba = *(const f32x4*)(cb + ch0), bb = *(const f32x4*)(cb + ch0 + 4);
                    float hv[8];
#pragma unroll
                    for (int e = 0; e < 8; ++e) { const float w0 = e < 4 ? w0a[e & 3] : w0b[e & 3], w1 = e < 4 ? w1a[e & 3] : w1b[e & 3], w2 = e < 4 ? w2a[e & 3] : w2b[e & 3], b0 = e < 4 ? ba[e & 3] : bb[e & 3];
                        hv[e] = gelu_tanh_f(b0 + w0 * u2[e] + w1 * u1[e] + w2 * uu[e]) * vv[e]; }
                    *(u32x4*)(UV + (size_t)row * UVW + DFF + ch0) = pack8(hv);
                    float* fo = nullptr;
                    if (row >= ROW_S && row < ROW_M) { const int s2 = row - ROW_S; if ((s2 & 7) >= 6) fo = p.out + O_CONVS + ((size_t)(s2 >> 3) * 2 + ((s2 & 7) - 6)) * DFF; }
                    else if (row >= NPR - 2 && row < NPR) fo = p.out + O_CONVP + (size_t)(row - (NPR - 2)) * DFF;
                    if (fo) { *(f32x4*)(fo + ch0) = acc[ai][0][m][0]; *(f32x4*)(fo + ch0 + 4) = acc[ai][0][m][1]; }
                    if (ai == 1 && wr == 1 && m == 3 && fr >= 14 && u.pm < 64) *(u32x4*)((u16*)(p.ws + W_HALO) + ((size_t)u.pm * 2 + (fr & 1)) * DFF + ch0) = pack8(uu);
                    if (ai == 0 && wr == 0 && m == 0) {
                        if (u.pm == 68 && fr >= 14) *(u32x4*)((u16*)(p.ws + W_HALO) + ((size_t)69 * 2 + (fr & 1)) * DFF + ch0) = pack8(uu);
                        if (u.pm < 64 && fr < 2) { *(u32x4*)((u16*)(p.ws + W_FIXU) + ((size_t)u.pm * 2 + fr) * DFF + ch0) = pack8(uu); *(u32x4*)((u16*)(p.ws + W_FIXV) + ((size_t)u.pm * 2 + fr) * DFF + ch0) = pack8(vv); }
                    }
                }
            }
        }
    }
};

__device__ __forceinline__ void meta_inproj(const Params& p, int bid, int w, int lane, int G) {
    const int fr = lane & 15, fq = lane >> 4;
    const u16* Xb = (const u16*)((const unsigned char*)p.out + OB_XB) + (size_t)(ROW_M + fr) * DM + fq * 8;
    const float* lb = (const float*)(p.ws + W_LB);
    for (int tile = w * G + bid; tile < INC / 16; tile += 8 * G) {
        const u16* Wr = (const u16*)(p.ws + W_WIN) + (size_t)(tile * 16 + fr) * DM + fq * 8;
        f32x4 a = {0.f, 0.f, 0.f, 0.f};
#pragma unroll 8
        for (int ks = 0; ks < 32; ++ks) {
            const bf16x8 bw = *(const bf16x8*)(Wr + ks * 32), ax = *(const bf16x8*)(Xb + ks * 32);
            a = __builtin_amdgcn_mfma_f32_16x16x32_bf16(bw, ax, a, 0, 0, 0);
        }
        const int col = tile * 16 + fq * 4, row = ROW_M + fr;
        float v[4] = {a[0], a[1], a[2], a[3]};
        u16* dst;
        if (col < 1024) { dst = (u16*)((unsigned char*)p.out + OB_Q) + (size_t)row * 1024 + col;
#pragma unroll
            for (int j = 0; j < 4; ++j) v[j] *= 0.125f; }
        else if (col < 1536) { dst = (u16*)((unsigned char*)p.out + OB_KV) + (size_t)row * 512 + (col - 1024);
            float* fo = p.out + (col < 1280 ? O_METAK : O_METAV) + (size_t)fr * 256 + (col & 255);
            *(f32x4*)fo = (f32x4){v[0], v[1], v[2], v[3]}; }
        else { const int g = (col - 1536) >> 10, c = (col - 1536) & 1023; dst = (u16*)(p.ws + W_S1 + (size_t)g * SLOT) + (size_t)row * 1024 + c;
            if (g == 1) { const f32x4 l4 = *(const f32x4*)(lb + c); unsigned hh[4];
#pragma unroll
                for (int j = 0; j < 4; ++j) { const float f = l4[j] + (1.0f - l4[j]) * sigmoidf_(v[j]); hh[j] = f2h(__logf(f)); }
                u32x2 wv; wv.x = hh[0] | (hh[1] << 16); wv.y = hh[2] | (hh[3] << 16); *(u32x2*)dst = wv; continue; } }
        u32x2 wv; wv.x = cvt_pk_bf16(v[0], v[1]); wv.y = cvt_pk_bf16(v[2], v[3]); *(u32x2*)dst = wv;
    }
}

__device__ __forceinline__ void transpose_tile(const float* W, int K, int N, u16* Wt, int tile, LAS float* sm, bool perm_up = false) {
    const int ntn = N / 64, tk = tile / ntn, tn = tile % ntn, tid = threadIdx.x;
    const int n0 = tn * 64, ch0 = n0 % DFF, nout = perm_up ? (ch0 / 128) * 256 + (ch0 % 128) + (n0 >= DFF ? 128 : 0) : n0;
#pragma unroll
    for (int i = 0; i < 8; ++i) { const int k = i * 8 + (tid >> 6), n = tid & 63; sm[k * 65 + n] = W[(size_t)(tk * 64 + k) * N + tn * 64 + n]; }
    __syncthreads();
    { const int n = tid >> 3, kg = tid & 7; float v[8];
#pragma unroll
      for (int j = 0; j < 8; ++j) v[j] = sm[(kg * 8 + j) * 65 + n];
      *(u32x4*)(Wt + (size_t)(nout + n) * K + tk * 64 + kg * 8) = pack8(v); }
    __syncthreads();
}

struct TDesc { const float* W; u16* Wt; int K, N, tile; bool perm, valid; };
__device__ __forceinline__ void transpose4(const TDesc (&d)[4], LAS float* sm) {
    const int tid = threadIdx.x;
    float r[4][8];
#pragma unroll
    for (int q = 0; q < 4; ++q) if (d[q].valid) { const int ntn = d[q].N / 64, tk = d[q].tile / ntn, tn = d[q].tile % ntn;
#pragma unroll
        for (int i = 0; i < 8; ++i) r[q][i] = __builtin_nontemporal_load(d[q].W + (size_t)(tk * 64 + i * 8 + (tid >> 6)) * d[q].N + tn * 64 + (tid & 63)); }
#pragma unroll
    for (int q = 0; q < 4; ++q) if (d[q].valid) {
#pragma unroll
        for (int i = 0; i < 8; ++i) sm[q * 4160 + (i * 8 + (tid >> 6)) * 65 + (tid & 63)] = r[q][i]; }
    __syncthreads();
#pragma unroll
    for (int q = 0; q < 4; ++q) if (d[q].valid) { const int ntn = d[q].N / 64, tk = d[q].tile / ntn, tn = d[q].tile % ntn;
        const int n0 = tn * 64, ch0 = n0 % DFF, nout = d[q].perm ? (ch0 / 128) * 256 + (ch0 % 128) + (n0 >= DFF ? 128 : 0) : n0;
        const int n = tid >> 3, kg = tid & 7; float v[8];
#pragma unroll
        for (int j = 0; j < 8; ++j) v[j] = sm[q * 4160 + (kg * 8 + j) * 65 + n];
        *(u32x4*)(d[q].Wt + (size_t)(nout + n) * d[q].K + tk * 64 + kg * 8) = pack8(v); }
    __syncthreads();
}

constexpr int KS_LD = 72, VT_LD = 296, NSLOT = 288;
constexpr int ATT_KS = 0, ATT_VT = NSLOT * KS_LD * 2, ATT_P = ATT_VT + 64 * VT_LD * 2;
static_assert(ATT_P + 8 * 16 * VT_LD * 2 <= LDS_BYTES, "attention LDS");

__device__ __forceinline__ void attn_rowtile(LAS const u16* Ks, LAS const u16* Vt, LAS u16* Pw, const u16* qptr, u16* optr,
                                             int tq, int meta_lim, int bs_min, int bs_max, int kk1, float sink, int lane) {
    const int fr = lane & 15, fq = lane >> 4;
    bf16x8 qf0 = *(const bf16x8*)(qptr + fq * 8), qf1 = *(const bf16x8*)(qptr + 32 + fq * 8);
    f32x4 s[12];
    __builtin_amdgcn_s_setprio(1);
#pragma unroll
    for (int i = 0; i < 12; ++i) {
        const int tile = (i < 2) ? i : 2 * kk1 + (i - 2);
        LAS const u16* kr = Ks + (tile * 16 + fr) * KS_LD + fq * 8;
        const bf16x8 k0 = *(LAS const bf16x8*)kr, k1 = *(LAS const bf16x8*)(kr + 32);
        f32x4 a = {0.f, 0.f, 0.f, 0.f};
        a = __builtin_amdgcn_mfma_f32_16x16x32_bf16(k0, qf0, a, 0, 0, 0);
        a = __builtin_amdgcn_mfma_f32_16x16x32_bf16(k1, qf1, a, 0, 0, 0);
        s[i] = a;
    }
    __builtin_amdgcn_s_setprio(0);
    float mx = sink;
#pragma unroll
    for (int i = 0; i < 12; ++i) {
        const int tile = (i < 2) ? i : 2 * kk1 + (i - 2);
#pragma unroll
        for (int jj = 0; jj < 4; ++jj) {
            const int slot = tile * 16 + fq * 4 + jj, bs = slot - 16;
            const bool vis = (slot < 16) ? (slot <= meta_lim) : (bs > tq && bs <= tq + 128 && bs >= bs_min && bs < bs_max);
            const float v = vis ? s[i][jj] : -1e30f; s[i][jj] = v; mx = fmaxf(mx, v);
        }
    }
    mx = fmaxf(mx, __shfl_xor(mx, 16)); mx = fmaxf(mx, __shfl_xor(mx, 32));
    float sum = 0.f;
#pragma unroll
    for (int i = 0; i < 12; ++i) {
        const int tile = (i < 2) ? i : 2 * kk1 + (i - 2);
        float pv[4];
#pragma unroll
        for (int jj = 0; jj < 4; ++jj) { pv[jj] = __expf(s[i][jj] - mx); sum += pv[jj]; }
        u32x2 w; w.x = cvt_pk_bf16(pv[0], pv[1]); w.y = cvt_pk_bf16(pv[2], pv[3]);
        *(LAS u32x2*)(Pw + fr * VT_LD + tile * 16 + fq * 4) = w;
    }
    sum += __shfl_xor(sum, 16); sum += __shfl_xor(sum, 32);
    const float inv = __builtin_amdgcn_rcpf(sum + __expf(sink - mx));
    asm volatile("s_waitcnt lgkmcnt(0)" ::: "memory"); __builtin_amdgcn_wave_barrier();
    f32x4 o[4];
#pragma unroll
    for (int dt = 0; dt < 4; ++dt) o[dt] = (f32x4){0.f, 0.f, 0.f, 0.f};
    __builtin_amdgcn_s_setprio(1);
#pragma unroll
    for (int ks = 0; ks < 6; ++ks) {
        const int kk = (ks == 0) ? 0 : kk1 + ks - 1;
        const bf16x8 pf = *(LAS const bf16x8*)(Pw + fr * VT_LD + kk * 32 + fq * 8);
#pragma unroll
        for (int dt = 0; dt < 4; ++dt) {
            const bf16x8 vf = *(LAS const bf16x8*)(Vt + (dt * 16 + fr) * VT_LD + kk * 32 + fq * 8);
            o[dt] = __builtin_amdgcn_mfma_f32_16x16x32_bf16(vf, pf, o[dt], 0, 0, 0);
        }
    }
    __builtin_amdgcn_s_setprio(0);
#pragma unroll
    for (int dt = 0; dt < 4; ++dt) {
        u32x2 w; w.x = cvt_pk_bf16(o[dt][0] * inv, o[dt][1] * inv); w.y = cvt_pk_bf16(o[dt][2] * inv, o[dt][3] * inv);
        *(u32x2*)(optr + dt * 16 + fq * 4) = w;
    }
    asm volatile("s_waitcnt lgkmcnt(0)" ::: "memory"); __builtin_amdgcn_wave_barrier();
}

__device__ __forceinline__ u32x4 kv_load8(const Params& p, int mode, int nb, int kvh, int slot, int dg, int isV) {
    const u16* KV = (const u16*)((const unsigned char*)p.out + OB_KV);
    const u32x4 z = {0u, 0u, 0u, 0u};
    if (mode == 0) {
        int row;
        if (slot < 16) row = ROW_M + slot;
        else if (slot < 272) { row = 128 * (nb - 2) + (slot - 16); if (nb < 1 || row < 0) return z; }
        else return z;
        return *(const u32x4*)(KV + (size_t)row * 512 + isV * 256 + kvh * 64 + dg * 8);
    } else {
        if (slot < 144) {
            const float* src = (slot < 16) ? p.in[2 + isV] + ((size_t)(nb * 16 + slot) * 4 + kvh) * 64 + dg * 8
                                           : p.in[4 + isV] + ((size_t)(nb * 128 + slot - 16) * 4 + kvh) * 64 + dg * 8;
            const f32x4 a = __builtin_nontemporal_load((const f32x4*)src), b = __builtin_nontemporal_load((const f32x4*)(src + 4));
            u32x4 w; w.x = cvt_pk_bf16(a[0], a[1]); w.y = cvt_pk_bf16(a[2], a[3]); w.z = cvt_pk_bf16(b[0], b[1]); w.w = cvt_pk_bf16(b[2], b[3]); return w;
        } else if (slot < 152) {
            return *(const u32x4*)(KV + (size_t)(ROW_S + nb * 8 + slot - 144) * 512 + isV * 256 + kvh * 64 + dg * 8);
        }
        return z;
    }
}

__device__ __forceinline__ void attn_load(const Params& p, int mode, int nb, int kvh, int nslots, u32x4 (&k)[5], u32x4 (&va)[3], u32x4 (&vb)[3]) {
    const int tid = threadIdx.x, np = nslots >> 1;
#pragma unroll
    for (int i = 0; i < 5; ++i) { const int c = tid + i * 512; if (c < nslots * 8) k[i] = kv_load8(p, mode, nb, kvh, c >> 3, c & 7, 0); }
#pragma unroll
    for (int i = 0; i < 3; ++i) { const int c = tid + i * 512; if (c < np * 8) { const int pr = c % np, dg = c / np;
        va[i] = kv_load8(p, mode, nb, kvh, 2 * pr, dg, 1); vb[i] = kv_load8(p, mode, nb, kvh, 2 * pr + 1, dg, 1); } }
}
__device__ __forceinline__ void attn_store(LAS unsigned char* lds, int nslots, const u32x4 (&k)[5], const u32x4 (&va)[3], const u32x4 (&vb)[3]) {
    LAS u16* Ks = (LAS u16*)(lds + ATT_KS); LAS u16* Vt = (LAS u16*)(lds + ATT_VT);
    const int tid = threadIdx.x, np = nslots >> 1;
#pragma unroll
    for (int i = 0; i < 5; ++i) { const int c = tid + i * 512; if (c < nslots * 8) *(LAS u32x4*)(Ks + (c >> 3) * KS_LD + (c & 7) * 8) = k[i]; }
#pragma unroll
    for (int i = 0; i < 3; ++i) { const int c = tid + i * 512; if (c < np * 8) { const int pr = c % np, dg = c / np;
        const u32x4 a = va[i], b = vb[i];
        LAS u16* d = Vt + (dg * 8) * VT_LD + 2 * pr;
        *(LAS unsigned*)(d + 0 * VT_LD) = (a.x & 0xffffu) | (b.x << 16);  *(LAS unsigned*)(d + 1 * VT_LD) = (a.x >> 16) | (b.x & 0xffff0000u);
        *(LAS unsigned*)(d + 2 * VT_LD) = (a.y & 0xffffu) | (b.y << 16);  *(LAS unsigned*)(d + 3 * VT_LD) = (a.y >> 16) | (b.y & 0xffff0000u);
        *(LAS unsigned*)(d + 4 * VT_LD) = (a.z & 0xffffu) | (b.z << 16);  *(LAS unsigned*)(d + 5 * VT_LD) = (a.z >> 16) | (b.z & 0xffff0000u);
        *(LAS unsigned*)(d + 6 * VT_LD) = (a.w & 0xffffu) | (b.w << 16);  *(LAS unsigned*)(d + 7 * VT_LD) = (a.w >> 16) | (b.w & 0xffff0000u); } }
}

__device__ __forceinline__ void attn_prompt_items(const Params& p, LAS unsigned char* lds, int bid, int G) {
    const int tid = threadIdx.x, lane = tid & 63, w = __builtin_amdgcn_readfirstlane(tid >> 6), fr = lane & 15;
    LAS const u16* Ks = (LAS const u16*)(lds + ATT_KS); LAS const u16* Vt = (LAS const u16*)(lds + ATT_VT);
    LAS u16* Pw = (LAS u16*)(lds + ATT_P) + w * 16 * VT_LD;
    u16* Q = (u16*)((unsigned char*)p.out + OB_Q);
    u32x4 k[5], va[3], vb[3];
    int it = bid;
    if (it >= 516) return;
    { const int nb = (it < 512) ? 1 + (it >> 2) : 0; attn_load(p, 0, nb, it & 3, nb == 0 ? 192 : NSLOT, k, va, vb); }
    for (; it < 516; it += G) {
        const int nb = (it < 512) ? 1 + (it >> 2) : 0, kvh = it & 3;
        attn_store(lds, nb == 0 ? 192 : NSLOT, k, va, vb);
        __syncthreads();
        { const int nx = it + G; if (nx < 516) { const int nb2 = (nx < 512) ? 1 + (nx >> 2) : 0; attn_load(p, 0, nb2, nx & 3, nb2 == 0 ? 192 : NSLOT, k, va, vb); } }
        if (nb > 0) {
            const int ts = w, tq = ts * 16 + fr, row = 128 * (nb - 1) + tq, kk1 = max(1, (1 + ts) >> 1);
            for (int gq = 0; gq < 4; ++gq) {
                const int head = kvh * 4 + gq;
                u16* qp = Q + (size_t)row * DM + head * 64;
                attn_rowtile(Ks, Vt, Pw, qp, qp, tq, 15, nb >= 2 ? 0 : 128, 256, kk1, p.in[10][head], lane);
            }
        } else if (w < 4) {
            const int head = kvh * 4 + w;
            u16* qp = Q + (size_t)(ROW_M + fr) * DM + head * 64;
            attn_rowtile(Ks, Vt, Pw, qp, qp, fr, fr, 128, 0, 1, p.in[10][head], lane);
        }
        __syncthreads();
    }
}
__device__ __forceinline__ void attn_sample_items(const Params& p, LAS unsigned char* lds, int bid, int G) {
    const int tid = threadIdx.x, lane = tid & 63, w = __builtin_amdgcn_readfirstlane(tid >> 6), fr = lane & 15;
    LAS const u16* Ks = (LAS const u16*)(lds + ATT_KS); LAS const u16* Vt = (LAS const u16*)(lds + ATT_VT);
    LAS u16* Pw = (LAS u16*)(lds + ATT_P) + w * 16 * VT_LD;
    u16* Q = (u16*)((unsigned char*)p.out + OB_Q);
    u32x4 k[5], va[3], vb[3];
    int it = bid;
    if (it >= 512) return;
    attn_load(p, 1, it >> 2, it & 3, 192, k, va, vb);
    for (; it < 512; it += G) {
        const int b = it >> 2, kvh = it & 3;
        attn_store(lds, 192, k, va, vb);
        __syncthreads();
        { const int nx = it + G; if (nx < 512) attn_load(p, 1, nx >> 2, nx & 3, 192, k, va, vb); }
        if (w < 2) {
            const int head = kvh * 4 + w * 2 + (fr >> 3), j = fr & 7;
            u16* qp = Q + (size_t)(ROW_S + b * 8 + j) * DM + head * 64;
            attn_rowtile(Ks, Vt, Pw, qp, qp, j, 15, 0, 136, 1, p.in[10][head], lane);
        }
        __syncthreads();
    }
}

constexpr int HQ_LD = 136, HK_LD = 72;
constexpr int H_QD = 0, H_KD = H_QD + 64 * HQ_LD * 2, H_KE = H_KD + 64 * HQ_LD * 2, H_VT = H_KE + 128 * HK_LD * 2, H_PM = H_VT + 128 * HK_LD * 2,
              H_ST = H_PM + 64 * HK_LD * 2, H_SEG = H_ST + 128 * HQ_LD * 2, H_DEC = H_SEG + 4096, H_LF = H_DEC + 512, H_END = H_LF + 64 * 128 * 4;
constexpr int H_VR = H_ST;
static_assert(H_END <= LDS_BYTES - 16, "hgrn LDS");

template <bool L3>
__device__ __forceinline__ void hgrn_prompt_item(const Params& p, LAS unsigned char* lds, int g, int h) {
    const int tid = threadIdx.x, lane = tid & 63, w = __builtin_amdgcn_readfirstlane(tid >> 6), fr = lane & 15, fq = lane >> 4;
    LAS u16* QD = (LAS u16*)(lds + H_QD); LAS u16* KD = (LAS u16*)(lds + H_KD); LAS u16* KEt = (LAS u16*)(lds + H_KE); LAS u16* Vt = (LAS u16*)(lds + H_VT);
    LAS u16* Pm = (LAS u16*)(lds + H_PM); LAS u16* St = (LAS u16*)(lds + H_ST); LAS float* segt = (LAS float*)(lds + H_SEG); LAS float* decs = (LAS float*)(lds + H_DEC);
    u16* HQ = (u16*)(p.ws + W_S1); const u16* LF = (const u16*)(p.ws + W_S2); const u16* HV = (const u16*)(p.ws + W_S3);
    float* Lb = (float*)(p.ws + W_L); float* Dg = (float*)(p.ws + W_DG);
    f32x4 S[8];
#pragma unroll
    for (int it = 0; it < 8; ++it) S[it] = (f32x4){0.f, 0.f, 0.f, 0.f};
    float gsum0 = 0.f, gsum1 = 0.f;
    if (L3) {
        const float* Lp = Lb + ((size_t)((g * 8 + h) * 8 + w) * 8) * 256;
#pragma unroll
        for (int it = 0; it < 8; ++it) S[it] = *(const f32x4*)(Lp + (it * 64 + lane) * 4);
    }
    LAS float* lfS = (LAS float*)(lds + H_LF); LAS u16* Vraw = (LAS u16*)(lds + H_VR);
    const int nchunks = (g == 0) ? 9 : 8;
#define HG_CHUNK_ROWS(ci_, r0_, nv_) do { if (g == 0) { if ((ci_) == 0) { r0_ = ROW_M; nv_ = 16; } else { r0_ = ((ci_) - 1) * 64; nv_ = 64; } } else { r0_ = g * 512 + (ci_) * 64; nv_ = 64; } } while (0)
    u32x4 pLF[2], pHV[2], pHQ[2];
#define HG_PREFETCH(ci_) do { int r0n_, nvn_; HG_CHUNK_ROWS(ci_, r0n_, nvn_); _Pragma("unroll") for (int rep = 0; rep < 2; ++rep) { \
        const int t_ = (tid >> 4) + rep * 32, c8_ = (tid & 15) * 8; const bool ok_ = t_ < nvn_; const size_t ga_ = (size_t)(r0n_ + t_) * DM + h * 128 + c8_; \
        const u32x4 z4_ = {0u, 0u, 0u, 0u}; pLF[rep] = ok_ ? *(const u32x4*)(LF + ga_) : z4_; pHV[rep] = ok_ ? *(const u32x4*)(HV + ga_) : z4_; \
        if (L3) pHQ[rep] = ok_ ? *(const u32x4*)(HQ + ga_) : z4_; } } while (0)
    HG_PREFETCH(0);
    for (int ci = 0; ci < nchunks; ++ci) {
        int r0, nvalid;
        HG_CHUNK_ROWS(ci, r0, nvalid);
#pragma unroll
        for (int rep = 0; rep < 2; ++rep) {
            const int t = (tid >> 4) + rep * 32, c8 = (tid & 15) * 8;
            const u32x4 lw = pLF[rep];
            f32x4 l0, l1;
            l0[0] = h2f((u16)(lw.x & 0xffffu)); l0[1] = h2f((u16)(lw.x >> 16)); l0[2] = h2f((u16)(lw.y & 0xffffu)); l0[3] = h2f((u16)(lw.y >> 16));
            l1[0] = h2f((u16)(lw.z & 0xffffu)); l1[1] = h2f((u16)(lw.z >> 16)); l1[2] = h2f((u16)(lw.w & 0xffffu)); l1[3] = h2f((u16)(lw.w >> 16));
            *(LAS f32x4*)(lfS + t * 128 + c8) = l0; *(LAS f32x4*)(lfS + t * 128 + c8 + 4) = l1;
            *(LAS u32x4*)(Vraw + t * 128 + c8) = pHV[rep];
            if (L3) *(LAS u32x4*)(QD + t * HQ_LD + c8) = pHQ[rep];
        }
        if (ci + 1 < nchunks) HG_PREFETCH(ci + 1);
        __syncthreads();
        {
            typedef float f32x2v __attribute__((ext_vector_type(2)));
            const int dk0 = (tid & 63) * 2, seg = tid >> 6;
            float lf0[8], lf1[8]; float run0 = 0.f, run1 = 0.f;
#pragma unroll
            for (int i = 0; i < 8; ++i) { const f32x2v l = *(LAS const f32x2v*)(lfS + (seg * 8 + i) * 128 + dk0); lf0[i] = l.x; lf1[i] = l.y; run0 += l.x; run1 += l.y; }
            *(LAS f32x2v*)(segt + seg * 128 + dk0) = (f32x2v){run0, run1};
            __syncthreads();
            float off0 = 0.f, off1 = 0.f, tot0 = 0.f, tot1 = 0.f;
#pragma unroll
            for (int s2 = 0; s2 < 8; ++s2) { const f32x2v v = *(LAS const f32x2v*)(segt + s2 * 128 + dk0); tot0 += v.x; tot1 += v.y; off0 += (s2 < seg) ? v.x : 0.f; off1 += (s2 < seg) ? v.y : 0.f; }
            gsum0 += tot0; gsum1 += tot1;
            if (seg == 0) *(LAS f32x2v*)(decs + dk0) = (f32x2v){__expf(tot0), __expf(tot1)};
            float b0 = off0, b1 = off1; unsigned ke0[4], ke1[4], vv0[4], vv1[4];
#pragma unroll
            for (int i = 0; i < 8; ++i) {
                const int t = seg * 8 + i; const bool ok = t < nvalid;
                b0 += lf0[i]; b1 += lf1[i];
                const float k0 = ok ? 1.0f - __expf(lf0[i]) : 0.f, k1 = ok ? 1.0f - __expf(lf1[i]) : 0.f;
                const unsigned e0 = f2bf(k0 * __expf(tot0 - b0)), e1 = f2bf(k1 * __expf(tot1 - b1));
                const unsigned vw = *(LAS const unsigned*)(Vraw + t * 128 + dk0);
                if (i & 1) { ke0[i >> 1] |= e0 << 16; ke1[i >> 1] |= e1 << 16; vv0[i >> 1] |= vw << 16; vv1[i >> 1] |= vw & 0xffff0000u; }
                else { ke0[i >> 1] = e0; ke1[i >> 1] = e1; vv0[i >> 1] = vw & 0xffffu; vv1[i >> 1] = vw >> 16; }
                if (L3) {
                    *(LAS unsigned*)(KD + t * HQ_LD + dk0) = cvt_pk_bf16(k0 * __expf(-b0), k1 * __expf(-b1));
                    const unsigned qw = *(LAS const unsigned*)(QD + t * HQ_LD + dk0);
                    const float q0 = bflo(qw), q1 = bfhi(qw);
                    *(LAS unsigned*)(QD + t * HQ_LD + dk0) = cvt_pk_bf16(q0 * sigmoidf_(q0) * __expf(b0), q1 * sigmoidf_(q1) * __expf(b1));
                }
            }
            *(LAS u32x4*)(KEt + dk0 * HK_LD + seg * 8) = (u32x4){ke0[0], ke0[1], ke0[2], ke0[3]};
            *(LAS u32x4*)(KEt + (dk0 + 1) * HK_LD + seg * 8) = (u32x4){ke1[0], ke1[1], ke1[2], ke1[3]};
            *(LAS u32x4*)(Vt + dk0 * HK_LD + seg * 8) = (u32x4){vv0[0], vv0[1], vv0[2], vv0[3]};
            *(LAS u32x4*)(Vt + (dk0 + 1) * HK_LD + seg * 8) = (u32x4){vv1[0], vv1[1], vv1[2], vv1[3]};
        }
        __syncthreads();
        bf16x8 vf[2];
#pragma unroll
        for (int ks = 0; ks < 2; ++ks) vf[ks] = *(LAS const bf16x8*)(Vt + (w * 16 + fr) * HK_LD + ks * 32 + fq * 8);
        if (L3) {
            const int tt = w >> 1;
#pragma unroll
            for (int si = 0; si < 2; ++si) {
                const int st = 2 * (w & 1) + si;
                f32x4 a = {0.f, 0.f, 0.f, 0.f};
                if (st <= tt) {
#pragma unroll
                    for (int ks = 0; ks < 4; ++ks) {
                        const bf16x8 kf = *(LAS const bf16x8*)(KD + (st * 16 + fr) * HQ_LD + ks * 32 + fq * 8);
                        const bf16x8 qf = *(LAS const bf16x8*)(QD + (tt * 16 + fr) * HQ_LD + ks * 32 + fq * 8);
                        a = __builtin_amdgcn_mfma_f32_16x16x32_bf16(kf, qf, a, 0, 0, 0);
                    }
                }
                const int t = tt * 16 + fr, s0 = st * 16 + fq * 4;
                u32x2 wv; wv.x = cvt_pk_bf16(s0 <= t ? a[0] : 0.f, s0 + 1 <= t ? a[1] : 0.f); wv.y = cvt_pk_bf16(s0 + 2 <= t ? a[2] : 0.f, s0 + 3 <= t ? a[3] : 0.f);
                *(LAS u32x2*)(Pm + t * HK_LD + s0) = wv;
            }
#pragma unroll
            for (int it = 0; it < 8; ++it) { u32x2 wv; wv.x = cvt_pk_bf16(S[it][0], S[it][1]); wv.y = cvt_pk_bf16(S[it][2], S[it][3]);
                *(LAS u32x2*)(St + (w * 16 + fr) * HQ_LD + it * 16 + fq * 4) = wv; }
            __syncthreads();
            bf16x8 sf[4];
            __builtin_amdgcn_s_setprio(1);
#pragma unroll
            for (int ks = 0; ks < 4; ++ks) sf[ks] = *(LAS const bf16x8*)(St + (w * 16 + fr) * HQ_LD + ks * 32 + fq * 8);
#pragma unroll
            for (int tt2 = 0; tt2 < 4; ++tt2) {
                f32x4 o = {0.f, 0.f, 0.f, 0.f};
#pragma unroll
                for (int ks = 0; ks < 2; ++ks) { const bf16x8 pf = *(LAS const bf16x8*)(Pm + (tt2 * 16 + fr) * HK_LD + ks * 32 + fq * 8); o = __builtin_amdgcn_mfma_f32_16x16x32_bf16(vf[ks], pf, o, 0, 0, 0); }
#pragma unroll
                for (int ks = 0; ks < 4; ++ks) { const bf16x8 qf = *(LAS const bf16x8*)(QD + (tt2 * 16 + fr) * HQ_LD + ks * 32 + fq * 8); o = __builtin_amdgcn_mfma_f32_16x16x32_bf16(sf[ks], qf, o, 0, 0, 0); }
                const int t = tt2 * 16 + fr;
                if (t < nvalid) { u32x2 wv; wv.x = cvt_pk_bf16(o[0], o[1]); wv.y = cvt_pk_bf16(o[2], o[3]); *(u32x2*)(HQ + (size_t)(r0 + t) * DM + h * 128 + w * 16 + fq * 4) = wv; }
            }
        }
        __builtin_amdgcn_s_setprio(1);
#pragma unroll
        for (int it = 0; it < 8; ++it) {
            const f32x4 d = *(LAS const f32x4*)(decs + it * 16 + fq * 4);
            f32x4 a = S[it] * d;
#pragma unroll
            for (int ks = 0; ks < 2; ++ks) { const bf16x8 kf = *(LAS const bf16x8*)(KEt + (it * 16 + fr) * HK_LD + ks * 32 + fq * 8); a = __builtin_amdgcn_mfma_f32_16x16x32_bf16(kf, vf[ks], a, 0, 0, 0); }
            S[it] = a;
        }
        __builtin_amdgcn_s_setprio(0);
        __syncthreads();
    }
    if (!L3) {
        float* Lp = Lb + ((size_t)((g * 8 + h) * 8 + w) * 8) * 256;
#pragma unroll
        for (int it = 0; it < 8; ++it) *(f32x4*)(Lp + (it * 64 + lane) * 4) = S[it];
        if (tid < 64) { Dg[(g * 8 + h) * 128 + 2 * tid] = __expf(gsum0); Dg[(g * 8 + h) * 128 + 2 * tid + 1] = __expf(gsum1); }
    } else if (g == 31) {
        float* o = p.out + O_HGP + (size_t)h * 16384;
#pragma unroll
        for (int it = 0; it < 8; ++it)
#pragma unroll
            for (int jj = 0; jj < 4; ++jj) o[(it * 16 + fq * 4 + jj) * 128 + w * 16 + fr] = S[it][jj];
    }
}

#undef HG_CHUNK_ROWS
#undef HG_PREFETCH
__device__ __forceinline__ void hgrn_sample_item(const Params& p, LAS unsigned char* lds, int b, int h) {
    const int tid = threadIdx.x;
    LAS float* qS = (LAS float*)lds; LAS float* dS = qS + 1024; LAS float* vS = dS + 1024; LAS float* part = vS + 1024;
    u16* HQ = (u16*)(p.ws + W_S1); const u16* LF = (const u16*)(p.ws + W_S2); const u16* HV = (const u16*)(p.ws + W_S3);
    const int dvq = tid & 31, dkg = tid >> 5;
    const float* s0 = p.in[6] + ((size_t)(b * 8 + h) * 128) * 128;
    f32x4 S[8];
#pragma unroll
    for (int i = 0; i < 8; ++i) S[i] = __builtin_nontemporal_load((const f32x4*)(s0 + (size_t)(dkg + 16 * i) * 128 + 4 * dvq));
    if (tid < 384) {
        const int arr = tid >> 7, j = (tid & 127) >> 4, c8 = (tid & 15) * 8; const size_t a = (size_t)(ROW_S + b * 8 + j) * DM + h * 128 + c8;
        const u32x4 w = *(const u32x4*)((arr == 0 ? LF : (arr == 1 ? (const u16*)HQ : HV)) + a);
        float f[8];
#pragma unroll
        for (int e = 0; e < 4; ++e) { const unsigned lo = w[e] & 0xffffu, hi = w[e] >> 16;
            if (arr == 0) { f[2 * e] = __expf(h2f((u16)lo)); f[2 * e + 1] = __expf(h2f((u16)hi)); }
            else if (arr == 1) { const float q0 = bf2f((u16)lo), q1 = bf2f((u16)hi); f[2 * e] = q0 * sigmoidf_(q0); f[2 * e + 1] = q1 * sigmoidf_(q1); }
            else { f[2 * e] = bf2f((u16)lo); f[2 * e + 1] = bf2f((u16)hi); } }
        LAS float* dst = (arr == 0 ? dS : (arr == 1 ? qS : vS)) + j * 128 + c8;
        *(LAS f32x4*)dst = (f32x4){f[0], f[1], f[2], f[3]}; *(LAS f32x4*)(dst + 4) = (f32x4){f[4], f[5], f[6], f[7]};
    }
    __syncthreads();
#pragma unroll
    for (int j = 0; j < 8; ++j) {
        const f32x4 v = *(LAS const f32x4*)(vS + j * 128 + 4 * dvq);
        f32x4 acc = {0.f, 0.f, 0.f, 0.f};
#pragma unroll
        for (int i = 0; i < 8; ++i) { const int dk = dkg + 16 * i; const float de = dS[j * 128 + dk], q = qS[j * 128 + dk]; const float k = 1.0f - de;
            S[i] = S[i] * de + v * k; acc += S[i] * q; }
        *(LAS f32x4*)(part + (j * 16 + dkg) * 128 + 4 * dvq) = acc;
    }
    float* so = p.out + O_HGS + ((size_t)(b * 8 + h) * 128) * 128;
#pragma unroll
    for (int i = 0; i < 8; ++i) __builtin_nontemporal_store(S[i], (f32x4*)(so + (size_t)(dkg + 16 * i) * 128 + 4 * dvq));
    __syncthreads();
    for (int idx = tid; idx < 1024; idx += 512) { const int j = idx >> 7, d = idx & 127; float s = 0.f;
#pragma unroll
        for (int k2 = 0; k2 < 16; ++k2) s += part[(j * 16 + k2) * 128 + d];
        HQ[(size_t)(ROW_S + b * 8 + j) * DM + h * 128 + d] = f2bf(s); }
    __syncthreads();
}

template <bool FIRST, int NB>
__device__ __forceinline__ void ln_rows(const Params& p, int rowb, int rstride, int lane, const float* gam, const float* bet) {
    u16* X1 = (u16*)(p.ws + W_S1);
    f32x4 x[NB][4];
#pragma unroll
    for (int b = 0; b < NB; ++b) { const u16* xr = X1 + (size_t)(rowb + b * rstride) * DM;
#pragma unroll
        for (int i = 0; i < 4; ++i) { const u32x2 xw = __builtin_nontemporal_load((const u32x2*)(xr + i * 256 + lane * 4)); x[b][i] = (f32x4){bflo(xw.x), bfhi(xw.x), bflo(xw.y), bfhi(xw.y)}; } }
    if (FIRST && NB == 1 && rowb >= ROW_S) {
        const float* pr = (const float*)(p.ws + W_S2) + (size_t)(rowb - ROW_S) * DM;
#pragma unroll
        for (int i = 0; i < 4; ++i) x[0][i] += *(const f32x4*)(pr + i * 256 + lane * 4);
    }
    if (!FIRST && NB == 1 && rowb >= ROW_S) {
        f32x4 pp[8][4];
#pragma unroll
        for (int sl = 0; sl < 8; ++sl) { const float* pr = part_row(p.ws, sl, rowb - ROW_S);
#pragma unroll
            for (int i = 0; i < 4; ++i) pp[sl][i] = *(const f32x4*)(pr + i * 256 + lane * 4); }
#pragma unroll
        for (int i = 0; i < 4; ++i) { f32x4 a = x[0][i] * ALPHA;
#pragma unroll
            for (int sl = 0; sl < 8; ++sl) a += pp[sl][i];
            x[0][i] = a; }
    }
#pragma unroll
    for (int b = 0; b < NB; ++b) {
        float* yr = yrow(p, rowb + b * rstride); const int row = rowb + b * rstride;
        float s = 0.f;
#pragma unroll
        for (int i = 0; i < 4; ++i) s += (x[b][i][0] + x[b][i][1]) + (x[b][i][2] + x[b][i][3]);
#pragma unroll
        for (int o = 1; o < 64; o <<= 1) s += __shfl_xor(s, o);
        const float mu = s * (1.0f / 1024.0f); float q = 0.f;
#pragma unroll
        for (int i = 0; i < 4; ++i) { const f32x4 d = x[b][i] - mu; q += (d[0] * d[0] + d[1] * d[1]) + (d[2] * d[2] + d[3] * d[3]); }
#pragma unroll
        for (int o = 1; o < 64; o <<= 1) q += __shfl_xor(q, o);
        const float rstd = rsqrtf(q * (1.0f / 1024.0f) + 1e-5f);
#pragma unroll
        for (int i = 0; i < 4; ++i) { const int c = i * 256 + lane * 4; const f32x4 gg = *(const f32x4*)(gam + c), bb = *(const f32x4*)(bet + c);
            const f32x4 y = (x[b][i] - mu) * rstd * gg + bb; if (!FIRST) __builtin_nontemporal_store(y, (f32x4*)(yr + c));
            if (FIRST) { u32x2 w; w.x = cvt_pk_bf16(y[0], y[1]); w.y = cvt_pk_bf16(y[2], y[3]); *(u32x2*)(X1 + (size_t)row * DM + c) = w; } }
    }
}
template <bool FIRST>
__device__ __forceinline__ void ln_phase(const Params& p, int bid, int wv, int lane, int G) {
    const float* gam = p.in[FIRST ? 14 : 20]; const float* bet = p.in[FIRST ? 15 : 21];
    const int r0 = bid * 8 + wv, st = G * 8;
    int i = 0;
    for (; r0 + st * (i + 3) < ROW_S; i += 4) ln_rows<FIRST, 4>(p, r0 + st * i, st, lane, gam, bet);
    for (; r0 + st * i < (FIRST ? MROWS : ROW_M); ++i) ln_rows<FIRST, 1>(p, r0 + st * i, st, lane, gam, bet);
}

#define XB_TMO      128
#define XB_XCNT(j)  (256  + 64 * (j))
#define XB_XSUB(j)  (1280 + 64 * (j))
#define XB_XGEN(j)  (2304 + 64 * (j))
#define XB_TOP      3328
#define XB_TOPGEN   3392
#define XCD_BAR_WORDS 3456
#define XB_SPIN_CAP (1u << 18)
static_assert(2 * XCD_BAR_WORDS * 4 <= CTL_BYTES, "barrier words");
__device__ __forceinline__ unsigned xb_ld(unsigned* p)              { return __hip_atomic_load(p, __ATOMIC_RELAXED, __HIP_MEMORY_SCOPE_AGENT); }
__device__ __forceinline__ unsigned xb_add(unsigned* p, unsigned v) { return __hip_atomic_fetch_add(p, v, __ATOMIC_RELAXED, __HIP_MEMORY_SCOPE_AGENT); }
__device__ __forceinline__ unsigned xb_xcc_id() { return (unsigned)__builtin_amdgcn_s_getreg((3 << 11) | 20) & 0xFu; }
#define XB_SPIN(cond, bar) do { unsigned _sp = 0; while (cond) { __builtin_amdgcn_s_sleep(1); \
    if ((++_sp & 255u) == 0u) { if (xb_ld(&(bar)[XB_TMO])) break; if (_sp > XB_SPIN_CAP) { atomicAdd(&(bar)[XB_TMO], 1u); break; } } } } while (0)
struct XcdBarrier { unsigned* bar; unsigned x; volatile LAS unsigned* st; };
__device__ __forceinline__ XcdBarrier xcd_barrier_post(unsigned* bar, volatile LAS unsigned* st) {
    XcdBarrier b; b.bar = bar; b.x = xb_xcc_id(); b.st = st;
    if (threadIdx.x == 0) (void)xb_add(&bar[XB_XCNT(b.x)], 1u);
    return b;
}
__device__ __forceinline__ void xcd_barrier_complete(unsigned* bar, unsigned x, unsigned& nloc, unsigned& nx) {
    const unsigned G = gridDim.x * gridDim.y * gridDim.z;
    unsigned sum, cnt, mine, sp = 0u;
    for (;;) {
        sum = 0u; cnt = 0u; mine = 0u;
#pragma unroll
        for (unsigned j = 0; j < 16; ++j) { const unsigned c = xb_ld(&bar[XB_XCNT(j)]); sum += c; cnt += (c > 0u) ? 1u : 0u; mine = (j == x) ? c : mine; }
        if (sum == G) break;
        __builtin_amdgcn_s_sleep(1);
        if ((++sp & 255u) == 0u) { if (xb_ld(&bar[XB_TMO])) break; if (sp > XB_SPIN_CAP) { atomicAdd(&bar[XB_TMO], 1u); break; } }
    }
    nloc = mine > 0u ? mine : 1u; nx = cnt > 0u ? cnt : 1u;
}
__device__ __forceinline__ void xcd_barrier(const XcdBarrier& b) {
    asm volatile("s_waitcnt vmcnt(0)" ::: "memory");
    __syncthreads();
    if (threadIdx.x == 0) {
        unsigned* bar = b.bar;
        __builtin_amdgcn_s_waitcnt(0);
        unsigned nloc = b.st[0], nx = b.st[1];
        if (nloc == 0u) { xcd_barrier_complete(bar, b.x, nloc, nx); b.st[0] = nloc; b.st[1] = nx; }
        const unsigned old = xb_add(&bar[XB_XSUB(b.x)], 1u);
        const unsigned gen = old / nloc;
        if (old + 1u == (gen + 1u) * nloc) {
            __builtin_amdgcn_fence(__ATOMIC_RELEASE, "agent");
            asm volatile("s_waitcnt vmcnt(0)" ::: "memory");
            const unsigned og = xb_add(&bar[XB_TOP], 1u);
            const unsigned tg = og / nx;
            if (og + 1u == (tg + 1u) * nx) xb_add(&bar[XB_TOPGEN], 1u);
            else XB_SPIN(xb_ld(&bar[XB_TOPGEN]) == tg, bar);
            __builtin_amdgcn_fence(__ATOMIC_ACQUIRE, "agent");
            xb_add(&bar[XB_XGEN(b.x)], 1u);
            asm volatile("s_waitcnt vmcnt(0)" ::: "memory");
        } else {
            XB_SPIN(xb_ld(&bar[XB_XGEN(b.x)]) == gen, bar);
            __builtin_amdgcn_fence(__ATOMIC_ACQUIRE, "agent");
            asm volatile("s_waitcnt vmcnt(0)" ::: "memory");
        }
    }
    __syncthreads();
}

__global__ void __launch_bounds__(512, 2) fwd_megakernel(Params p) {
    extern __shared__ __attribute__((aligned(16))) unsigned char lds_raw[];
    LAS unsigned char* lds = (LAS unsigned char*)lds_raw;
    cg::grid_group grid = cg::this_grid();
    const int tid = threadIdx.x, lane = tid & 63, wv = tid >> 6, G = gridDim.x, bid = blockIdx.x;
    const size_t gtid = (size_t)bid * 512 + tid, gthreads = (size_t)G * 512;
    volatile LAS unsigned* bst = (volatile LAS unsigned*)(lds + LDS_BYTES - 16);
    if (tid == 0) { bst[0] = 0u; bst[1] = 0u; }
    __syncthreads();
    const XcdBarrier gbar = xcd_barrier_post((unsigned*)(p.ws + W_CTL) + p.bli * XCD_BAR_WORDS, bst);
    if (p.ph_lo < 0) grid.sync();

#define IN(k) (p.ph_lo <= (k) && (k) < p.ph_hi)
#define SEAM(k) do { if (IN(k) && IN((k) + 1)) xcd_barrier(gbar); } while (0)
    {
        if (IN(0)) {
            for (int t0 = bid; t0 < 1920 + 256; t0 += 4 * G) {
                TDesc d[4];
#pragma unroll
                for (int q = 0; q < 4; ++q) { const int t = t0 + q * G; d[q].valid = t < 1920 + 256; d[q].perm = false; d[q].K = DM;
                    if (t < 1920) { d[q].W = p.in[9]; d[q].Wt = (u16*)(p.ws + W_WIN); d[q].N = INC; d[q].tile = t; }
                    else { d[q].W = p.in[13]; d[q].Wt = (u16*)(p.ws + W_WOUT); d[q].N = DM; d[q].tile = t - 1920; } }
                transpose4(d, (LAS float*)lds);
            }
            u16* Xb = (u16*)((unsigned char*)p.out + OB_XB);
            for (size_t it = gtid; it < (size_t)MROWS * 128; it += gthreads) { const int row = (int)(it >> 7), cgp = (int)(it & 127);
                const float* s = xrow(p, row) + cgp * 8; const f32x4 a = __builtin_nontemporal_load((const f32x4*)s), b = __builtin_nontemporal_load((const f32x4*)(s + 4));
                u32x4 w; w.x = cvt_pk_bf16(a[0], a[1]); w.y = cvt_pk_bf16(a[2], a[3]); w.z = cvt_pk_bf16(b[0], b[1]); w.w = cvt_pk_bf16(b[2], b[3]);
                *(u32x4*)(Xb + (size_t)row * DM + cgp * 8) = w; }
            if (bid == 0) for (int c = tid; c < 1024; c += 512) { const float a0 = p.in[11][c], a1 = p.in[11][1024 + c], mm = fmaxf(a0, a1), e0 = __expf(a0 - mm), e1 = __expf(a1 - mm);
                ((float*)(p.ws + W_LB))[c] = e0 / (e0 + e1); }
}
        SEAM(0);
        if (IN(1)) {
            pg8::Gemm g{(const u16*)((unsigned char*)p.out + OB_XB), (const u16*)(p.ws + W_WIN), MPAD, INC, DM, DM, DM};
            pg8::StaticOrder S; S.init(ROW_M, INC, DM, G, bid);
            EpiIn E{p};
            pg8::gemm_phase<EpiIn, pg8::StaticOrder>(lds, g, S, E);
            meta_inproj(p, bid, __builtin_amdgcn_readfirstlane(wv), lane, G);
        }
        SEAM(1);
        if (IN(2)) {
            for (int it = bid; it < 256; it += G) hgrn_prompt_item<false>(p, lds, it >> 3, it & 7);
            attn_prompt_items(p, lds, bid, G);
            attn_sample_items(p, lds, bid, G);
            for (int it = bid; it < 1024; it += G) hgrn_sample_item(p, lds, it >> 3, it & 7);
        }
        SEAM(2);
        if (IN(3)) {
            float* Lb = (float*)(p.ws + W_L); const float* Dg = (const float*)(p.ws + W_DG);
            for (int e = bid * 512 + tid; e < 131072; e += G * 512) {
                const int hh = e >> 14, itq = (e >> 8) & 7, ln = (e >> 2) & 63, jj = e & 3, dk = itq * 16 + (ln >> 4) * 4 + jj;
                float Sx = 0.f;
#pragma unroll 8
                for (int gg = 0; gg < 32; ++gg) { const float l = Lb[(size_t)gg * 131072 + e], d = Dg[(gg * 8 + hh) * 128 + dk]; Lb[(size_t)gg * 131072 + e] = Sx; Sx = d * Sx + l; }
            }
            xcd_barrier(gbar);
        }
        if (IN(3)) {
            for (int it = bid; it < 256; it += G) hgrn_prompt_item<true>(p, lds, it >> 3, it & 7);
        }
        SEAM(3);
        if (IN(4)) {
            const u16* OH = (const u16*)(p.ws + W_S1); u16* HG = (u16*)(p.ws + W_S4); const u16* GA = (const u16*)(p.ws + W_S5); const u16* GB = (const u16*)(p.ws + W_S6);
            const u16* OA = (const u16*)((const unsigned char*)p.out + OB_Q); const float* ng = p.in[12];
            for (int row0 = bid * 8 + wv; row0 < MROWS; row0 += G * 16) {
                u32x4 oh[2][2], hgv[2][2], gav[2][2], gbv[2][2], oav[2][2];
#pragma unroll
                for (int rr = 0; rr < 2; ++rr) { const int row = min(row0 + rr * G * 8, MROWS - 1);
#pragma unroll
                    for (int hf = 0; hf < 2; ++hf) { const size_t a = (size_t)row * DM + hf * 512 + lane * 8;
                        oh[rr][hf] = __builtin_nontemporal_load((const u32x4*)(OH + a)); hgv[rr][hf] = __builtin_nontemporal_load((const u32x4*)(HG + a)); gav[rr][hf] = __builtin_nontemporal_load((const u32x4*)(GA + a)); gbv[rr][hf] = __builtin_nontemporal_load((const u32x4*)(GB + a)); oav[rr][hf] = __builtin_nontemporal_load((const u32x4*)(OA + a)); } }
#pragma unroll
                for (int rr = 0; rr < 2; ++rr) {
                    const int row = row0 + rr * G * 8;
                    float ss = 0.f;
#pragma unroll
                    for (int hf = 0; hf < 2; ++hf)
#pragma unroll
                        for (int j = 0; j < 4; ++j) { const float a = bflo(oh[rr][hf][j]), b = bfhi(oh[rr][hf][j]); ss += a * a + b * b; }
#pragma unroll
                    for (int o = 1; o < 64; o <<= 1) ss += __shfl_xor(ss, o);
                    const float rstd = rsqrtf(ss * (1.0f / 1024.0f) + 1e-6f);
                    if (row < MROWS) {
#pragma unroll
                        for (int hf = 0; hf < 2; ++hf) { const size_t a = (size_t)row * DM + hf * 512 + lane * 8;
                            const u32x4 hg = hgv[rr][hf], ga = gav[rr][hf], gb = gbv[rr][hf], oa = oav[rr][hf];
                            const f32x4 n0 = *(const f32x4*)(ng + hf * 512 + lane * 8), n1 = *(const f32x4*)(ng + hf * 512 + lane * 8 + 4);
                            float v[8];
#pragma unroll
                            for (int j = 0; j < 4; ++j) {
                                const float g0 = (j < 2) ? n0[2 * j] : n1[2 * j - 4], g1 = (j < 2) ? n0[2 * j + 1] : n1[2 * j - 3];
                                const float h0 = bflo(hg[j]), h1 = bfhi(hg[j]);
                                v[2 * j] = sigmoidf_(bflo(ga[j])) * bflo(oa[j]) + sigmoidf_(bflo(gb[j])) * (bflo(oh[rr][hf][j]) * rstd * g0) * (h0 * sigmoidf_(h0));
                                v[2 * j + 1] = sigmoidf_(bfhi(ga[j])) * bfhi(oa[j]) + sigmoidf_(bfhi(gb[j])) * (bfhi(oh[rr][hf][j]) * rstd * g1) * (h1 * sigmoidf_(h1));
                            }
                            *(u32x4*)(HG + a) = pack8(v); }
                    }
                }
            }
        }
        SEAM(4);
        if (IN(5)) {
            pg8::Gemm g{(const u16*)(p.ws + W_S4), (const u16*)(p.ws + W_WOUT), MPAD, DM, DM, DM, DM};
            pg8::TailOrder S; S.init(DM, G, bid);
            EpiRes1 E{p};
            pg8::gemm_phase<EpiRes1, pg8::TailOrder>(lds, g, S, E);
            if (bid >= 40) {
                for (int t0 = bid - 40; t0 < 1408 + 704; t0 += 4 * (G - 40)) {
                    TDesc d[4];
#pragma unroll
                    for (int q = 0; q < 4; ++q) { const int t = t0 + q * (G - 40); d[q].valid = t < 1408 + 704;
                        if (t < 1408) { d[q].W = p.in[16]; d[q].Wt = (u16*)(p.ws + W_WUP); d[q].K = DM; d[q].N = UVW; d[q].tile = t; d[q].perm = true; }
                        else { d[q].W = p.in[19]; d[q].Wt = (u16*)(p.ws + W_WDN); d[q].K = DFF; d[q].N = DM; d[q].tile = t - 1408; d[q].perm = false; } }
                    transpose4(d, (LAS float*)lds);
                }
                for (size_t it = (size_t)(bid - 40) * 512 + tid; it < (size_t)2 * NBATCH * 120 * 64; it += (size_t)(G - 40) * 512) { const int sel = (int)(it / ((size_t)NBATCH * 120 * 64)); const size_t r = it % ((size_t)NBATCH * 120 * 64);
                    const int b = (int)(r / (120 * 64)), q = (int)(r % (120 * 64));
                    const f32x4 v = __builtin_nontemporal_load((const f32x4*)(p.in[4 + sel] + ((size_t)b * 128 + 8) * 256 + (size_t)q * 4));
                    __builtin_nontemporal_store(v, (f32x4*)(p.out + (sel ? O_WINVS : O_WINKS) + (size_t)b * 128 * 256 + (size_t)q * 4)); }
                    }
        }
        SEAM(5);
        if (IN(6)) {
            ln_phase<true>(p, bid, wv, lane, G);
        }
        SEAM(6);
        if (IN(7)) {
            pg8::Gemm g{(const u16*)(p.ws + W_S1), (const u16*)(p.ws + W_WUP), MPAD, UVW, DM, DM, DM};
            pg8::StaticOrder S; S.init(MPAD, UVW, DM, G, bid);
            EpiUp E{p, (LAS float*)(lds + 131072)};
            pg8::gemm_phase<EpiUp, pg8::StaticOrder>(lds, g, S, E);
        }
        SEAM(7);
        if (IN(9)) {
            pg8::Gemm g{(const u16*)(p.ws + W_UV) + DFF, (const u16*)(p.ws + W_WDN), MPAD, DM, DFF, UVW, DFF};
            pg8::SplitOrder S; S.init(DFF, G, bid);
            {
                pg8::Unit u0;
                if (S.next(0, u0)) {
                    u16* UV = (u16*)(p.ws + W_UV); const float* cw = p.in[17]; const float* cb = p.in[18];
                    const u16* HA = (const u16*)(p.ws + W_HALO) + (size_t)(u0.pm == 0 ? 69 : u0.pm - 1) * 2 * DFF;
                    const u16* FU = (const u16*)(p.ws + W_FIXU) + (size_t)u0.pm * 2 * DFF; const u16* FV = (const u16*)(p.ws + W_FIXV) + (size_t)u0.pm * 2 * DFF;
                    for (int idx = tid; idx < 2 * 352; idx += 512) {
                        const int r = idx / 352, c = (idx % 352) * 8;
                        const u32x4 h0 = *(const u32x4*)(HA + c), h1 = *(const u32x4*)(HA + DFF + c), f0 = *(const u32x4*)(FU + c), f1 = *(const u32x4*)(FU + DFF + c), fv = *(const u32x4*)(FV + (size_t)r * DFF + c);
                        const u32x4 a2 = r == 0 ? h0 : h1, a1 = r == 0 ? h1 : f0, a0 = r == 0 ? f0 : f1;
                        const f32x4 w0a = *(const f32x4*)(cw + c), w0b = *(const f32x4*)(cw + c + 4), w1a = *(const f32x4*)(cw + DFF + c), w1b = *(const f32x4*)(cw + DFF + c + 4),
                                    w2a = *(const f32x4*)(cw + 2 * DFF + c), w2b = *(const f32x4*)(cw + 2 * DFF + c + 4), ba = *(const f32x4*)(cb + c), bb = *(const f32x4*)(cb + c + 4);
                        float hv[8];
#pragma unroll
                        for (int e = 0; e < 8; ++e) {
                            const float x2 = (e & 1) ? bfhi(a2[e >> 1]) : bflo(a2[e >> 1]), x1 = (e & 1) ? bfhi(a1[e >> 1]) : bflo(a1[e >> 1]), x0 = (e & 1) ? bfhi(a0[e >> 1]) : bflo(a0[e >> 1]);
                            const float vl = (e & 1) ? bfhi(fv[e >> 1]) : bflo(fv[e >> 1]);
                            const float w0 = e < 4 ? w0a[e & 3] : w0b[e & 3], w1 = e < 4 ? w1a[e & 3] : w1b[e & 3], w2 = e < 4 ? w2a[e & 3] : w2b[e & 3], b0 = e < 4 ? ba[e & 3] : bb[e & 3];
                            hv[e] = gelu_tanh_f(b0 + w0 * x2 + w1 * x1 + w2 * x0) * vl;
                        }
                        *(u32x4*)(UV + (size_t)(u0.pm * 256 + r) * UVW + DFF + c) = pack8(hv);
                    }
                    __threadfence();
                    __syncthreads();
                }
            }
            EpiRes2 E{p};
            pg8::gemm_phase<EpiRes2, pg8::SplitOrder>(lds, g, S, E);
        }
        SEAM(9);
        if (IN(10)) ln_phase<false>(p, bid, wv, lane, G);
    }
}

constexpr int N_PHASES = 11;
#ifndef PH_HI
#define PH_HI N_PHASES
#endif

extern "C" void kernel_launch(void* const* d_in, const int* in_sizes, int n_in, void* d_out, int out_size, void* d_ws, size_t ws_size, hipStream_t stream) {
    static int grid_blocks = 0;
    if (!grid_blocks) {
        if (n_in != 22 || ws_size < WS_NEED || out_size != 43922944) { fprintf(stderr, "kernel_launch: unexpected problem (n_in %d, ws %zu, out %d)\n", n_in, ws_size, out_size); grid_blocks = -1; return; }
        int dev = 0, cus = 0, per_cu = 0;
        hipGetDevice(&dev);
        hipDeviceGetAttribute(&cus, hipDeviceAttributeMultiprocessorCount, dev);
        hipFuncSetAttribute((const void*)fwd_megakernel, hipFuncAttributeMaxDynamicSharedMemorySize, LDS_BYTES);
        hipOccupancyMaxActiveBlocksPerMultiprocessor(&per_cu, (const void*)fwd_megakernel, 512, LDS_BYTES);
        if (per_cu < 1) { fprintf(stderr, "kernel_launch: occupancy query says %d blocks per CU\n", per_cu); per_cu = 1; }
        grid_blocks = cus;
    }
    if (grid_blocks < 0) return;
    Params p{};
    for (int i = 0; i < 22; ++i) p.in[i] = (const float*)d_in[i];
    p.out = (float*)d_out; p.ws = (unsigned char*)d_ws;
    (void)hipMemsetAsync((unsigned char*)d_ws + W_CTL, 0, CTL_BYTES, stream);
#ifdef PREFIX_K
    { Params q = p; q.ph_lo = 0; q.ph_hi = PREFIX_K; q.bli = 1; void* a2[] = {&q};
      hipLaunchCooperativeKernel((const void*)fwd_megakernel, dim3(grid_blocks), dim3(512), a2, LDS_BYTES, stream); }
#endif
    p.ph_lo = 0; p.ph_hi = PH_HI;
    void* args[] = {&p};
    hipError_t e = hipLaunchCooperativeKernel((const void*)fwd_megakernel, dim3(grid_blocks), dim3(512), args, LDS_BYTES, stream);
    if (e != hipSuccess) fprintf(stderr, "cooperative launch failed: %s (grid %d)\n", hipGetErrorString(e), grid_blocks);
}
```
